# Optimizing an MI355X kernel written in HIP

```python
import math
import jax, jax.numpy as jnp
from jax import lax
import numpy as np

D_MODEL = 1024
BATCH = 2
SEQ = 8192
DEPTH = 1
DEC_BATCH = 128
DEC_SEQ = 4
PAST_LEN = 8192
PAGE_SIZE = 128

HEAD_DIM = 64
ATT_WIDTH = D_MODEL // 2
ATT_HEADS = ATT_WIDTH // HEAD_DIM
SSM_WIDTH = D_MODEL - ATT_WIDTH
SSM_CH = 16
SSM_GROUPS = SSM_WIDTH // SSM_CH
SSM_STATE = 64
DILATIONS = ((128, 1), (512, 4), (2048, 16))
MAX_SPAN = max(w for w, _ in DILATIONS)
Q_BLOCK = 128
FFN_HIDDEN = -(-8 * D_MODEL // (3 * 256)) * 256
N_MOD = 6
EPS = 1e-6

kernel_name = 'hymba_s5_longnet_decode_step'


def rms_norm(x, gain):
    xf = x.astype(jnp.float32)
    return xf * lax.rsqrt(jnp.mean(xf * xf, axis=-1, keepdims=True) + EPS) * gain.astype(jnp.float32)


def ada_modulation(c, w_ada, b_ada):
    mod = jax.nn.silu(c.astype(jnp.float32)) @ w_ada.astype(jnp.float32) + b_ada.astype(jnp.float32)
    return jnp.split(mod[:, None, :], N_MOD, axis=-1)


def combine_dilations(outs, lses):
    w = jax.nn.softmax(jnp.stack(lses, axis=0), axis=0)
    return jnp.einsum('pbth,pbthd->bthd', w, jnp.stack(outs, axis=0))


def dilated_band_attention(q, k, v, dil, n_back):
    b, s, h, dh = q.shape
    n = s // dil
    n_pad = -(-n // Q_BLOCK) * Q_BLOCK
    nb = n_pad // Q_BLOCK
    z = b * dil

    def to_sub(a):
        a = a.reshape(b, n, dil, h, dh).transpose(0, 2, 1, 3, 4).reshape(z, n, h, dh)
        return jnp.pad(a, ((0, 0), (0, n_pad - n), (0, 0), (0, 0)))

    qs, ks, vs = to_sub(q), to_sub(k), to_sub(v)
    front = ((0, 0), (Q_BLOCK, 0), (0, 0), (0, 0))

    def blocks_with_prev(a):
        a = jnp.pad(a, front)
        prev = a[:, :n_pad].reshape(z, nb, Q_BLOCK, h, dh)
        cur = a[:, Q_BLOCK:].reshape(z, nb, Q_BLOCK, h, dh)
        return jnp.concatenate([prev, cur], axis=2)

    kb, vb = blocks_with_prev(ks), blocks_with_prev(vs)
    qb = qs.reshape(z, nb, Q_BLOCK, h, dh)
    scores = jnp.einsum('znqhd,znkhd->znhqk', qb, kb) * (HEAD_DIM ** -0.5)
    qi = jnp.arange(Q_BLOCK)[:, None]
    ki = jnp.arange(2 * Q_BLOCK)[None, :]
    dist = qi + Q_BLOCK - ki
    blk = jnp.arange(nb)[:, None, None]
    valid = (dist >= 0) & (dist <= n_back) & (blk * Q_BLOCK - Q_BLOCK + ki >= 0)
    scores = jnp.where(valid[None, :, None], scores, -jnp.inf)
    lse = jax.nn.logsumexp(scores, axis=-1)
    p = jnp.exp(scores - lse[..., None])
    o = jnp.einsum('znhqk,znkhd->znqhd', p, vb).reshape(z, n_pad, h, dh)[:, :n]
    lse = lse.transpose(0, 1, 3, 2).reshape(z, n_pad, h)[:, :n]
    o = o.reshape(b, dil, n, h, dh).transpose(0, 2, 1, 3, 4).reshape(b, s, h, dh)
    lse = lse.reshape(b, dil, n, h).transpose(0, 2, 1, 3).reshape(b, s, h)
    return o, lse


def dilated_gather_attention(q, k_all, v_all, n_past):
    t = q.shape[1]
    outs, lses = [], []
    for window, dil in DILATIONS:
        n_back = window // dil
        idx = n_past + jnp.arange(t)[:, None] - dil * jnp.arange(n_back + 1)[None, :]
        valid = idx >= 0
        idx = jnp.maximum(idx, 0)
        kg, vg = k_all[:, idx], v_all[:, idx]
        scores = jnp.einsum('bthd,btmhd->bthm', q, kg) * (HEAD_DIM ** -0.5)
        scores = jnp.where(valid[None, :, None, :], scores, -jnp.inf)
        lse = jax.nn.logsumexp(scores, axis=-1)
        p = jnp.exp(scores - lse[..., None])
        outs.append(jnp.einsum('bthm,btmhd->bthd', p, vg))
        lses.append(lse)
    return combine_dilations(outs, lses)


def attend_prompt(q, k, v):
    outs, lses = [], []
    for window, dil in DILATIONS:
        o, l = dilated_band_attention(q, k, v, dil, window // dil)
        outs.append(o)
        lses.append(l)
    keep = min(MAX_SPAN, q.shape[1])
    return combine_dilations(outs, lses), k[:, -keep:], v[:, -keep:]


def make_sample_attend(cache_k, cache_v):
    def attend(q, k, v):
        n_past, t = cache_k.shape[1], q.shape[1]
        k_all = jnp.concatenate([cache_k.astype(jnp.float32), k], axis=1)
        v_all = jnp.concatenate([cache_v.astype(jnp.float32), v], axis=1)
        o = dilated_gather_attention(q, k_all, v_all, n_past)
        return o, k_all[:, t:], v_all[:, t:]
    return attend


def _linear_combine(left, right):
    a_l, b_l = left
    a_r, b_r = right
    return a_r * a_l, a_r * b_l + b_r


def s5_mixer(u, h0, a_re, a_im, log_dt, b_re, b_im, c_re, c_im, d_skip, w_glu):
    f32 = jnp.float32
    bsz, t, _ = u.shape
    u = u.astype(f32)
    a = lax.complex(a_re.astype(f32), a_im.astype(f32))
    dt = jnp.exp(log_dt.astype(f32))[:, None]
    a_bar = jnp.exp(dt * a)
    b_bar = ((a_bar - 1.0) / a)[..., None] * lax.complex(b_re.astype(f32), b_im.astype(f32))
    c_mat = lax.complex(c_re.astype(f32), c_im.astype(f32))
    ug = u.reshape(bsz, t, SSM_GROUPS, SSM_CH).astype(jnp.complex64)
    bu = jnp.einsum('btgc,gnc->btgn', ug, b_bar)
    if h0 is not None:
        bu = bu.at[:, 0].add(a_bar * h0)
    a_seq = jnp.broadcast_to(a_bar, bu.shape)
    _, h = lax.associative_scan(_linear_combine, (a_seq, bu), axis=1)
    y = jnp.einsum('gcn,btgn->btgc', c_mat, h).real.reshape(bsz, t, SSM_WIDTH) + d_skip.astype(f32) * u
    y = jax.nn.gelu(y)
    y = y * jax.nn.sigmoid(y @ w_glu.astype(f32))
    return y, h[:, -1]


def decoder_layer(x, c, attend, h0, norm1_g, norm2_g, w_ada, b_ada, w_in, q_gain, k_gain,
                  ssm_a_re, ssm_a_im, ssm_log_dt, ssm_b_re, ssm_b_im, ssm_c_re, ssm_c_im, ssm_d, w_glu,
                  attn_out_g, ssm_out_g, w_out, w_gate, w_up, w_down):
    f32 = jnp.float32
    bsz, t, _ = x.shape
    shift1, scale1, gate1, shift2, scale2, gate2 = ada_modulation(c, w_ada, b_ada)
    h = rms_norm(x, norm1_g) * (1.0 + scale1) + shift1
    zcols = h @ w_in.astype(f32)
    q = zcols[..., :ATT_WIDTH].reshape(bsz, t, ATT_HEADS, HEAD_DIM)
    k = zcols[..., ATT_WIDTH:2 * ATT_WIDTH].reshape(bsz, t, ATT_HEADS, HEAD_DIM)
    v = zcols[..., 2 * ATT_WIDTH:3 * ATT_WIDTH].reshape(bsz, t, ATT_HEADS, HEAD_DIM)
    u = zcols[..., 3 * ATT_WIDTH:]
    q = rms_norm(q, q_gain)
    k = rms_norm(k, k_gain)
    o_att, k_keep, v_keep = attend(q, k, v)
    y_ssm, h_last = s5_mixer(u, h0, ssm_a_re, ssm_a_im, ssm_log_dt, ssm_b_re, ssm_b_im,
                             ssm_c_re, ssm_c_im, ssm_d, w_glu)
    merged = jnp.concatenate([rms_norm(o_att.reshape(bsz, t, ATT_WIDTH), attn_out_g),
                              rms_norm(y_ssm, ssm_out_g)], axis=-1)
    x1 = x.astype(f32) + gate1 * (merged @ w_out.astype(f32))
    h2 = rms_norm(x1, norm2_g) * (1.0 + scale2) + shift2
    ff = (jax.nn.silu(h2 @ w_gate.astype(f32)) * (h2 @ w_up.astype(f32))) @ w_down.astype(f32)
    y = x1 + gate2 * ff
    return y.astype(x.dtype), k_keep, v_keep, h_last


def setup_inputs(seed: int = 0) -> dict:
    key = jax.random.key(seed)
    ks = jax.random.split(key, 32)
    f32 = jnp.float32
    L = DEPTH
    n_buf = min(MAX_SPAN, PAST_LEN)

    def nrm(k, shape, scale):
        return jax.random.normal(k, shape, f32) * scale

    n_idx = jnp.arange(SSM_STATE, dtype=f32)
    return {
        'x_prompt': nrm(ks[0], (BATCH, SEQ, D_MODEL), 1.0),
        'x_sample': nrm(ks[1], (DEC_BATCH, DEC_SEQ, D_MODEL), 1.0),
        'cache_k': nrm(ks[2], (L, DEC_BATCH, n_buf, ATT_HEADS, HEAD_DIM), 1.0),
        'cache_v': nrm(ks[3], (L, DEC_BATCH, n_buf, ATT_HEADS, HEAD_DIM), 1.0),
        'state_ssm_re': nrm(ks[4], (L, DEC_BATCH, SSM_GROUPS, SSM_STATE), 0.3),
        'state_ssm_im': nrm(ks[5], (L, DEC_BATCH, SSM_GROUPS, SSM_STATE), 0.3),
        'c_prompt': nrm(ks[6], (BATCH, D_MODEL), 1.0),
        'c_sample': nrm(ks[7], (DEC_BATCH, D_MODEL), 1.0),
        'norm1_g': 1.0 + nrm(ks[8], (L, D_MODEL), 0.02),
        'norm2_g': 1.0 + nrm(ks[9], (L, D_MODEL), 0.02),
        'w_ada': nrm(ks[10], (L, D_MODEL, N_MOD * D_MODEL), 0.5 * D_MODEL ** -0.5),
        'b_ada': nrm(ks[11], (L, N_MOD * D_MODEL), 0.02),
        'w_in': nrm(ks[12], (L, D_MODEL, 3 * ATT_WIDTH + SSM_WIDTH), D_MODEL ** -0.5),
        'q_gain': 1.0 + nrm(ks[13], (L, HEAD_DIM), 0.02),
        'k_gain': 1.0 + nrm(ks[14], (L, HEAD_DIM), 0.02),
        'ssm_a_re': -0.5 + nrm(ks[15], (L, SSM_GROUPS, SSM_STATE), 0.01),
        'ssm_a_im': math.pi * n_idx + nrm(ks[16], (L, SSM_GROUPS, SSM_STATE), 0.01),
        'ssm_log_dt': jax.random.uniform(ks[17], (L, SSM_GROUPS), f32, math.log(1e-3), math.log(1e-1)),
        'ssm_b_re': nrm(ks[18], (L, SSM_GROUPS, SSM_STATE, SSM_CH), (2 * SSM_CH) ** -0.5),
        'ssm_b_im': nrm(ks[19], (L, SSM_GROUPS, SSM_STATE, SSM_CH), (2 * SSM_CH) ** -0.5),
        'ssm_c_re': nrm(ks[20], (L, SSM_GROUPS, SSM_CH, SSM_STATE), (2 * SSM_STATE) ** -0.5),
        'ssm_c_im': nrm(ks[21], (L, SSM_GROUPS, SSM_CH, SSM_STATE), (2 * SSM_STATE) ** -0.5),
        'ssm_d': nrm(ks[22], (L, SSM_WIDTH), 1.0),
        'w_glu': nrm(ks[23], (L, SSM_WIDTH, SSM_WIDTH), SSM_WIDTH ** -0.5),
        'attn_out_g': 1.0 + nrm(ks[24], (L, ATT_WIDTH), 0.02),
        'ssm_out_g': 1.0 + nrm(ks[25], (L, SSM_WIDTH), 0.02),
        'w_out': nrm(ks[26], (L, D_MODEL, D_MODEL), D_MODEL ** -0.5),
        'w_gate': nrm(ks[27], (L, D_MODEL, FFN_HIDDEN), D_MODEL ** -0.5),
        'w_up': nrm(ks[28], (L, D_MODEL, FFN_HIDDEN), D_MODEL ** -0.5),
        'w_down': nrm(ks[29], (L, FFN_HIDDEN, D_MODEL), FFN_HIDDEN ** -0.5),
    }


def reference(x_prompt, x_sample, cache_k, cache_v, state_ssm_re, state_ssm_im, c_prompt, c_sample,
              norm1_g, norm2_g, w_ada, b_ada, w_in, q_gain, k_gain,
              ssm_a_re, ssm_a_im, ssm_log_dt, ssm_b_re, ssm_b_im, ssm_c_re, ssm_c_im, ssm_d, w_glu,
              attn_out_g, ssm_out_g, w_out, w_gate, w_up, w_down):
    f32 = jnp.float32
    xp, xs = x_prompt, x_sample
    kp_l, vp_l, hp_l, ks_l, vs_l, hs_l = [], [], [], [], [], []
    for layer in range(DEPTH):
        w = tuple(p[layer] for p in (norm1_g, norm2_g, w_ada, b_ada, w_in, q_gain, k_gain,
                                     ssm_a_re, ssm_a_im, ssm_log_dt, ssm_b_re, ssm_b_im, ssm_c_re, ssm_c_im,
                                     ssm_d, w_glu, attn_out_g, ssm_out_g, w_out, w_gate, w_up, w_down))
        xp, kp, vp, hp = decoder_layer(xp, c_prompt, attend_prompt, None, *w)
        h0 = lax.complex(state_ssm_re[layer].astype(f32), state_ssm_im[layer].astype(f32))
        xs, ks_, vs_, hs = decoder_layer(xs, c_sample, make_sample_attend(cache_k[layer], cache_v[layer]), h0, *w)
        kp_l.append(kp); vp_l.append(vp); hp_l.append(hp)
        ks_l.append(ks_); vs_l.append(vs_); hs_l.append(hs)
    hp_all = jnp.stack(hp_l, axis=0)
    hs_all = jnp.stack(hs_l, axis=0)
    return (xp, xs, jnp.stack(kp_l, axis=0), jnp.stack(vp_l, axis=0), hp_all.real, hp_all.imag,
            jnp.stack(ks_l, axis=0), jnp.stack(vs_l, axis=0), hs_all.real, hs_all.imag)
```

```cpp
#include <hip/hip_runtime.h>
#include <cstdio>
#include <cstdint>

#ifndef MK_MULTI
#define MK_MULTI 0
#endif

#define LAS __attribute__((address_space(3)))
#define GAS __attribute__((address_space(1)))
typedef unsigned short bf16_t;
typedef short bf16x8 __attribute__((ext_vector_type(8)));
typedef short s16x4 __attribute__((ext_vector_type(4)));
typedef float f32x4 __attribute__((ext_vector_type(4)));
typedef float f32x2 __attribute__((ext_vector_type(2)));
typedef unsigned u32x4 __attribute__((ext_vector_type(4)));
typedef unsigned u32x2 __attribute__((ext_vector_type(2)));

constexpr int D = 1024, SEQ = 8192, MP = 16384, MS = 512, M = MP + MS;
constexpr int KVB = 2048, NIN = 2048, FF = 2816, NMOD = 6144, NGU = 2 * FF;
constexpr int KA = 384;
constexpr int NMODROWS = 130;
constexpr float EPS = 1e-6f;
constexpr float LOG2E = 1.4426950408889634f;
constexpr float QSCALE = 0.125f * LOG2E;

constexpr size_t OFF_Y0 = 0, OFF_Y1 = 16777216, OFF_KP = 17301504, OFF_VP = 19398656, OFF_HRP = 21495808, OFF_HIP = 21499904,
                 OFF_KS = 21504000, OFF_VS = 155721728, OFF_HRS = 289939456, OFF_HIS = 290201600;

constexpr size_t MiB = 1u << 20;
constexpr size_t WS_CTL = 0, CTL_ZERO_BYTES = 1 * MiB;
constexpr size_t WS_WADA = 1 * MiB;
constexpr size_t WS_WIN = 13 * MiB;
constexpr size_t WS_WGLU = 17 * MiB;
constexpr size_t WS_WOUT = 18 * MiB;
constexpr size_t WS_WGU = 20 * MiB;
constexpr size_t WS_WDN = 31 * MiB;
constexpr size_t WS_TMAT = 37 * MiB;
constexpr size_t WS_WEND = 43 * MiB;
constexpr size_t WS_CS = 47 * MiB;
constexpr size_t WS_MOD = 48 * MiB;
constexpr size_t WS_XN = 52 * MiB;
constexpr size_t WS_Q = 86 * MiB;
constexpr size_t WS_K = 102 * MiB;
constexpr size_t WS_V = 118 * MiB;
constexpr size_t WS_QS = 134 * MiB;
constexpr size_t WS_US = 135 * MiB;
constexpr size_t WS_AP = 136 * MiB;
constexpr size_t WS_SST = 160 * MiB;
constexpr size_t WS_YG = 176 * MiB;
constexpr size_t WS_MRG = 193 * MiB;
constexpr size_t WS_X1 = 227 * MiB;
constexpr size_t WS_HB = 294 * MiB;
constexpr size_t WS_STAT = 385 * MiB;
constexpr size_t WS_END = 386 * MiB;
constexpr int CW_TMO = 0, CW_BAR = 4096;
constexpr int CW_S5C = 20480;
constexpr int CW_CPCTR = 8192, CW_QP = 8256, CW_QS = 8320, CW_DONE = 8448;

constexpr int RING_BYTES = 131072, LDSCTL_OFF = RING_BYTES, MISC_OFF = LDSCTL_OFF + 320, LDS_BYTES = 147456;
constexpr int NWAVES = 8;

__device__ __forceinline__ unsigned cvt_pk_bf16(float lo, float hi) { unsigned r; asm volatile("v_cvt_pk_bf16_f32 %0, %1, %2" : "=v"(r) : "v"(lo), "v"(hi)); return r; }
__device__ __forceinline__ float bf2f(unsigned short b) { return __uint_as_float((unsigned)b << 16); }
__device__ __forceinline__ float bflo(unsigned w) { return __uint_as_float(w << 16); }
__device__ __forceinline__ float bfhi(unsigned w) { return __uint_as_float(w & 0xffff0000u); }
template <int CTRL> __device__ __forceinline__ float dpp_mov(float v) { return __int_as_float(__builtin_amdgcn_update_dpp(0, __float_as_int(v), CTRL, 0xf, 0xf, true)); }
__device__ __forceinline__ float row16_sum(float v) {
    v += dpp_mov<0xB1>(v);
    v += dpp_mov<0x4E>(v);
    v += dpp_mov<0x141>(v);
    v += dpp_mov<0x140>(v);
    return v;
}
__device__ __forceinline__ float rdlane(float v, int l) { return __int_as_float(__builtin_amdgcn_readlane(__float_as_int(v), l)); }
__device__ __forceinline__ float wave_sum(float v) {
    v = row16_sum(v);
    return (rdlane(v, 0) + rdlane(v, 16)) + (rdlane(v, 32) + rdlane(v, 48));
}
__device__ __forceinline__ float fexp2(float x) { return __builtin_amdgcn_exp2f(x); }
__device__ __forceinline__ float frcp(float x) { return __builtin_amdgcn_rcpf(x); }
__device__ __forceinline__ float sigmoidf_(float x) { return frcp(1.0f + fexp2(-x * LOG2E)); }
__device__ __forceinline__ float siluf_(float x) { return x * sigmoidf_(x); }
__device__ __forceinline__ float gelu_tanh(float x) { const float z = 0.7978845608028654f * (x + 0.044715f * x * x * x); return x * frcp(1.0f + fexp2(-2.0f * LOG2E * z)); }
__device__ __forceinline__ u32x4 pack8(f32x4 a, f32x4 b) { u32x4 w; w.x = cvt_pk_bf16(a[0], a[1]); w.y = cvt_pk_bf16(a[2], a[3]); w.z = cvt_pk_bf16(b[0], b[1]); w.w = cvt_pk_bf16(b[2], b[3]); return w; }

__device__ __forceinline__ void wt16f(const void* base, unsigned off, f32x4 v) { __builtin_amdgcn_raw_buffer_store_b128(__builtin_bit_cast(u32x4, v), __builtin_amdgcn_make_buffer_rsrc((void*)base, 0, 0xffffffffu, 0x00020000), (int)off, 0, 16); }

__device__ __forceinline__ double dexp_small(double x) {
    const double y = x * 0.125;
    double t = 1.0 + y * (1.0 / 12.0);
    t = 1.0 + t * y * (1.0 / 11.0); t = 1.0 + t * y * (1.0 / 10.0); t = 1.0 + t * y * (1.0 / 9.0); t = 1.0 + t * y * (1.0 / 8.0); t = 1.0 + t * y * (1.0 / 7.0); t = 1.0 + t * y * (1.0 / 6.0);
    t = 1.0 + t * y * (1.0 / 5.0); t = 1.0 + t * y * (1.0 / 4.0); t = 1.0 + t * y * (1.0 / 3.0); t = 1.0 + t * y * (1.0 / 2.0); t = 1.0 + t * y;
    t = t * t; t = t * t; t = t * t; return t;
}
__device__ __forceinline__ void dsincos(double a, double& s, double& c) {
    const double k = __builtin_rint(a * 0.63661977236758134308);
    const double y = (a - k * 1.57079632679489655800) - k * 6.123233995736766036e-17;
    const double y2 = y * y;
    const double sp = y * (1.0 + y2 * (-1.0 / 6 + y2 * (1.0 / 120 + y2 * (-1.0 / 5040 + y2 * (1.0 / 362880 + y2 * (-1.0 / 39916800 + y2 * (1.0 / 6227020800.0)))))));
    const double cp = 1.0 + y2 * (-0.5 + y2 * (1.0 / 24 + y2 * (-1.0 / 720 + y2 * (1.0 / 40320 + y2 * (-1.0 / 3628800 + y2 * (1.0 / 479001600.0 + y2 * (-1.0 / 87178291200.0)))))));
    const long long q = (long long)k & 3;
    s = (q == 0) ? sp : (q == 1) ? cp : (q == 2) ? -sp : -cp;
    c = (q == 0) ? cp : (q == 1) ? -sp : (q == 2) ? -cp : sp;
}
__device__ __forceinline__ void abar_pow(double j, double dt, double lr, double li, double& re, double& im) {
    const double mag = dexp_small(j * dt * lr); double s, c; dsincos(j * dt * li, s, c); re = mag * c; im = mag * s;
}

namespace pg8 {
constexpr int BM = 256, BK = 64, HALF = 128, HTB = HALF * BK * 2, STAGE_BYTES = 8 * HTB;
__host__ __device__ __forceinline__ int lds_byte(int r, int c) { const int st = (r >> 4) * 2 + (c >> 5), rr = r & 15, cc = c & 31, ob = rr * 64 + cc * 2; return st * 1024 + (ob ^ (((ob >> 9) & 1) << 5)); }
__host__ __device__ __forceinline__ void stage_rc(int b, int& R, int& C) { const int st = b / 1024, sb = b % 1024, swz = sb ^ (((sb >> 9) & 1) << 5); R = (st >> 1) * 16 + swz / 64; C = (st & 1) * 32 + (swz % 64) / 2; }
__host__ __device__ __forceinline__ int perm32(int rho) { const int n = rho >> 4, i = rho & 15; return 8 * (i >> 2) + 4 * n + (i & 3); }

struct Unit { int pm, pn; const char* a; const char* b; };

struct StaticOrder {
    const char* A; const char* B; int nM, nN, G, c; size_t strideA, strideB;
    __device__ __forceinline__ bool next(int i, Unit& u) const {
        const int L = i * G + c; if (L >= nM * nN) return false;
        u.pm = L / nN; u.pn = L - u.pm * nN; u.a = A + (size_t)u.pm * strideA; u.b = B + (size_t)u.pn * strideB; return true;
    }
};
struct GroupOrder {
    const char* A; const char* B; int nM, G, c; size_t strideA, strideB;
    __device__ __forceinline__ bool next(int i, Unit& u) const {
        const int L = i * G + c; if (L >= nM) return false;
        u.pm = L; u.pn = 0; u.a = A + (size_t)L * strideA; u.b = B + (size_t)(L >> 2) * strideB; return true;
    }
};

template <class Epi, class Sched, bool ALIGN_EPI>
__device__ __forceinline__ void gemm_phase(LAS unsigned char* lds, const int K, const int lda, const int ldb, const Sched& S, const Epi& E) {
    const int tid = threadIdx.x, wid = __builtin_amdgcn_readfirstlane(tid >> 6), lane = tid & 63, wr = wid >> 2, wc = wid & 3, fr = lane & 15, fq = lane >> 4;
    const int nt = K / BK;
    unsigned voffA[2], voffB[2];
#pragma unroll
    for (int i = 0; i < 2; ++i) { int R, C; stage_rc(tid * 16 + i * 8192, R, C); const int Rb = (R & ~31) + perm32(R & 31);
        voffA[i] = (unsigned)(R * lda + C) * 2u; voffB[i] = (unsigned)(Rb * ldb + C) * 2u; }
    const size_t kstep = (size_t)(BK * 2);
    const size_t hstepA = (size_t)HALF * lda * 2, hstepB = (size_t)HALF * ldb * 2;
    const unsigned ldsw = (unsigned)wid * 1024u;
    const int aoff = lds_byte(wr * 64 + fr, fq * 8), boff = lds_byte(wc * 32 + fr, fq * 8);
#define PG8_SA(b, h) (((b) * 2 + (h)) * HTB)
#define PG8_SB(b, h) ((4 + (b) * 2 + (h)) * HTB)
#define PG8_STAGE(bufoff, gbase, voff) do { _Pragma("unroll") for (int _i = 0; _i < 2; ++_i) { unsigned _vo = (voff)[_i]; asm volatile("" : "+v"(_vo)); \
        __builtin_amdgcn_global_load_lds((const unsigned*)((const char*)(gbase) + _vo), (LAS unsigned*)(lds + (bufoff) + ldsw + _i * 8192), 16, 0, 0); } } while (0)
#define PG8_LDA(dst, b, h) do { _Pragma("unroll") for (int m = 0; m < 4; ++m) _Pragma("unroll") for (int k = 0; k < 2; ++k) dst[m][k] = *(const LAS bf16x8*)(lds + PG8_SA(b, h) + aoff + m * 2048 + k * 1024); } while (0)
#define PG8_LDB(dst, b, h) do { _Pragma("unroll") for (int n = 0; n < 2; ++n) _Pragma("unroll") for (int k = 0; k < 2; ++k) dst[n][k] = *(const LAS bf16x8*)(lds + PG8_SB(b, h) + boff + n * 2048 + k * 1024); } while (0)
#define PG8_MMA(ai, bj, At, Bt) do { __builtin_amdgcn_s_setprio(1); _Pragma("unroll") for (int m = 0; m < 4; ++m) _Pragma("unroll") for (int n = 0; n < 2; ++n) _Pragma("unroll") for (int k = 0; k < 2; ++k) \
        acc[ai][bj][m][n] = __builtin_amdgcn_mfma_f32_16x16x32_bf16(Bt[n][k], At[m][k], acc[ai][bj][m][n], 0, 0, 0); __builtin_amdgcn_s_setprio(0); } while (0)
#define PG8_WAIT_V(n) asm volatile("s_waitcnt vmcnt(" #n ")" ::: "memory")
#define PG8_WAIT_L(n) asm volatile("s_waitcnt lgkmcnt(" #n ")" ::: "memory")
#define PG8_BAR __builtin_amdgcn_s_barrier()
#define PG8_SCHED __builtin_amdgcn_sched_barrier(0)
    Unit cur, nxt; int ui = 0;
    if (!S.next(0, cur)) return;
    f32x4 acc[2][2][4][2];
#pragma unroll
    for (int a = 0; a < 2; ++a)
#pragma unroll
        for (int b = 0; b < 2; ++b)
#pragma unroll
            for (int m = 0; m < 4; ++m)
#pragma unroll
                for (int n = 0; n < 2; ++n) acc[a][b][m][n] = (f32x4){0.f, 0.f, 0.f, 0.f};
    bf16x8 At[4][2], B0[2][2], B1[2][2];
    const char* cA = cur.a; const char* cB = cur.b;
    PG8_STAGE(PG8_SB(0, 0), cB, voffB); PG8_STAGE(PG8_SB(0, 1), cB + hstepB, voffB); PG8_STAGE(PG8_SA(0, 0), cA, voffA); PG8_STAGE(PG8_SA(0, 1), cA + hstepA, voffA);
    if (wr == 1) PG8_BAR;
    PG8_WAIT_V(2); PG8_BAR;
    PG8_STAGE(PG8_SB(1, 0), cB + kstep, voffB); PG8_STAGE(PG8_SA(1, 0), cA + kstep, voffA); PG8_STAGE(PG8_SB(1, 1), cB + hstepB + kstep, voffB);
    PG8_WAIT_V(6); PG8_BAR;
    for (;;) {
        const bool has_next = S.next(ui + 1, nxt);
        const char* nA = has_next ? nxt.a : cA; const char* nB = has_next ? nxt.b : cB;
        for (int t = 0; t < nt; t += 2) {
            if constexpr (Epi::MIDK) { if (t == (nt >> 1)) E.mid(acc, cur, wr, fr); }
            const bool last = (t == nt - 2);
            const char* a1 = cA + (size_t)(t + 1) * kstep;
            const char* a2 = last ? nA : cA + (size_t)(t + 2) * kstep; const char* b2 = last ? nB : cB + (size_t)(t + 2) * kstep;
            const char* a3 = a2 + kstep; const char* b3 = b2 + kstep;
            PG8_LDB(B0, 0, 0); PG8_LDB(B1, 0, 1); PG8_SCHED; PG8_LDA(At, 0, 0); PG8_STAGE(PG8_SA(1, 1), a1 + hstepA, voffA);
            PG8_WAIT_V(8); PG8_WAIT_L(0); PG8_BAR; PG8_MMA(0, 0, At, B0); PG8_MMA(0, 1, At, B1); PG8_BAR; PG8_SCHED;
            PG8_LDA(At, 0, 1); PG8_STAGE(PG8_SB(0, 0), b2, voffB); PG8_STAGE(PG8_SB(0, 1), b2 + hstepB, voffB); PG8_STAGE(PG8_SA(0, 0), a2, voffA);
            PG8_WAIT_V(8); PG8_WAIT_L(0); PG8_BAR; PG8_MMA(1, 0, At, B0); PG8_MMA(1, 1, At, B1); PG8_BAR; PG8_SCHED;
            PG8_LDB(B0, 1, 0); PG8_LDB(B1, 1, 1); PG8_SCHED; PG8_LDA(At, 1, 0); PG8_STAGE(PG8_SA(0, 1), a2 + hstepA, voffA);
            PG8_WAIT_V(8); PG8_WAIT_L(0); PG8_BAR; PG8_MMA(0, 0, At, B0); PG8_MMA(0, 1, At, B1); PG8_BAR; PG8_SCHED;
            PG8_LDA(At, 1, 1); PG8_STAGE(PG8_SB(1, 0), b3, voffB); PG8_STAGE(PG8_SB(1, 1), b3 + hstepB, voffB); PG8_STAGE(PG8_SA(1, 0), a3, voffA);
            PG8_WAIT_V(8); PG8_WAIT_L(0); PG8_BAR; PG8_MMA(1, 0, At, B0); PG8_MMA(1, 1, At, B1); PG8_BAR; PG8_SCHED;
        }
        if constexpr (ALIGN_EPI) { if (wr == 0) PG8_BAR; }
        E(acc, cur, wr, wc, fr, fq);
        if (!has_next) break;
#pragma unroll
        for (int a = 0; a < 2; ++a)
#pragma unroll
            for (int b = 0; b < 2; ++b)
#pragma unroll
                for (int m = 0; m < 4; ++m)
#pragma unroll
                    for (int n = 0; n < 2; ++n) acc[a][b][m][n] = (f32x4){0.f, 0.f, 0.f, 0.f};
        cur = nxt; cA = nA; cB = nB; ++ui;
        if constexpr (ALIGN_EPI) { if (wr == 1) PG8_BAR; }
    }
    PG8_WAIT_V(0);
    if constexpr (!ALIGN_EPI) { if (wr == 0) PG8_BAR; }
    PG8_BAR;
#undef PG8_SA
#undef PG8_SB
#undef PG8_STAGE
#undef PG8_LDA
#undef PG8_LDB
#undef PG8_MMA
#undef PG8_WAIT_V
#undef PG8_WAIT_L
#undef PG8_BAR
#undef PG8_SCHED
}
}
using pg8::Unit;
typedef f32x4 Acc[2][2][4][2];

__device__ __forceinline__ int mod_row(int row) { return row < MP ? (row >> 13) : 2 + ((row - MP) >> 2); }

struct EpiMod {
    static constexpr bool MIDK = false;
    float* MOD; const float* bada;
    __device__ __forceinline__ void operator()(const Acc& acc, const Unit& u, int wr, int wc, int fr, int fq) const {
        asm volatile("" : "+v"(fr), "+v"(fq));
#pragma unroll
        for (int ai = 0; ai < 2; ++ai)
#pragma unroll
            for (int m = 0; m < 4; ++m) { const int row = u.pm * 256 + ai * 128 + wr * 64 + m * 16 + fr;
                if (row < NMODROWS) {
#pragma unroll
                    for (int bj = 0; bj < 2; ++bj) { const int col = u.pn * 256 + bj * 128 + wc * 32 + 8 * fq;
                        const f32x4 b0 = *(const f32x4*)(bada + col), b1 = *(const f32x4*)(bada + col + 4);
                        *(f32x4*)(MOD + (size_t)row * NMOD + col) = acc[ai][bj][m][0] + b0; *(f32x4*)(MOD + (size_t)row * NMOD + col + 4) = acc[ai][bj][m][1] + b1; } } }
    }
};
struct EpiIn {
    static constexpr bool MIDK = false;
    bf16_t *Qb, *Kb, *Vb, *AP; float *QS, *US, *out; const float *qg, *kg;
    __device__ __forceinline__ void operator()(const Acc& acc, const Unit& u, int wr, int wc, int fr, int fq) const {
        asm volatile("" : "+v"(fr), "+v"(fq));
        const int kind = u.pn >> 1, half = u.pn & 1, head = 4 * half + wc;
        const bool prompt = u.pm < 64;
        f32x4 g00 = {1.f, 1.f, 1.f, 1.f}, g01 = g00, g10 = g00, g11 = g00;
        if (kind <= 1) { const float* gp = kind == 0 ? qg : kg; g00 = *(const f32x4*)(gp + 8 * fq); g01 = *(const f32x4*)(gp + 8 * fq + 4); g10 = *(const f32x4*)(gp + 32 + 8 * fq); g11 = *(const f32x4*)(gp + 32 + 8 * fq + 4); }
#pragma unroll
        for (int ai = 0; ai < 2; ++ai)
#pragma unroll
            for (int m = 0; m < 4; ++m) {
                const int row = u.pm * 256 + ai * 128 + wr * 64 + m * 16 + fr;
                f32x4 a0 = acc[ai][0][m][0], a1 = acc[ai][0][m][1], b0 = acc[ai][1][m][0], b1 = acc[ai][1][m][1];
                if (kind <= 1) {
                    float ss = 0.f;
#pragma unroll
                    for (int e = 0; e < 4; ++e) ss += a0[e] * a0[e] + a1[e] * a1[e] + b0[e] * b0[e] + b1[e] * b1[e];
                    ss += __shfl_xor(ss, 16); ss += __shfl_xor(ss, 32);
                    float rs = __builtin_amdgcn_rsqf(ss * (1.0f / 64.0f) + EPS);
                    if (kind == 0) rs *= QSCALE;
                    a0 = a0 * g00 * rs; a1 = a1 * g01 * rs; b0 = b0 * g10 * rs; b1 = b1 * g11 * rs;
                }
                const int c0 = head * 64 + 8 * fq;
                if (kind == 0) {
                    if (prompt) { *(u32x4*)(Qb + (size_t)row * 512 + c0) = pack8(a0, a1); *(u32x4*)(Qb + (size_t)row * 512 + c0 + 32) = pack8(b0, b1); }
                    else { const unsigned o_ = ((unsigned)(row - MP) * 512u + c0) * 4u; wt16f(QS, o_, a0); wt16f(QS, o_ + 16u, a1); wt16f(QS, o_ + 128u, b0); wt16f(QS, o_ + 144u, b1); }
                } else if (kind <= 2) {
                    bf16_t* Bb = kind == 1 ? Kb : Vb; float* o = out + (kind == 1 ? OFF_KP : OFF_VP); float* os = out + (kind == 1 ? OFF_KS : OFF_VS);
                    if (prompt) {
                        *(u32x4*)(Bb + (size_t)row * 512 + c0) = pack8(a0, a1); *(u32x4*)(Bb + (size_t)row * 512 + c0 + 32) = pack8(b0, b1);
                        const int b = row >> 13, t = row & 8191;
                        if (t >= SEQ - KVB) { float* p = o + ((size_t)b * KVB + (t - (SEQ - KVB))) * 512 + c0; *(f32x4*)p = a0; *(f32x4*)(p + 4) = a1; *(f32x4*)(p + 32) = b0; *(f32x4*)(p + 36) = b1; }
                    } else {
                        const int rs_ = row - MP, bs = rs_ >> 2, t = rs_ & 3;
                        const unsigned o_ = (((unsigned)bs * KVB + (KVB - 4) + t) * 512u + c0) * 4u; wt16f(os, o_, a0); wt16f(os, o_ + 16u, a1); wt16f(os, o_ + 128u, b0); wt16f(os, o_ + 144u, b1);
                    }
                } else {
                    if (prompt) {
                        const int g0 = 16 * half + 4 * wc + (fq >> 1), cc = 8 * (fq & 1);
                        bf16_t* p0 = AP + ((size_t)g0 * 1024 + (row >> 4)) * KA + (row & 15) * 16 + cc;
                        *(u32x4*)p0 = pack8(a0, a1); *(u32x4*)(p0 + (size_t)2 * 1024 * KA) = pack8(b0, b1);
                    } else { const unsigned o_ = ((unsigned)(row - MP) * 512u + c0) * 4u; wt16f(US, o_, a0); wt16f(US, o_ + 16u, a1); wt16f(US, o_ + 128u, b0); wt16f(US, o_ + 144u, b1); }
                }
            }
    }
};
struct EpiSt {
    static constexpr bool MIDK = false;
    float* SST;
    __device__ __forceinline__ void operator()(const Acc& acc, const Unit& u, int wr, int wc, int fr, int fq) const {
        asm volatile("" : "+v"(fr), "+v"(fq));
#pragma unroll
        for (int ai = 0; ai < 2; ++ai)
#pragma unroll
            for (int m = 0; m < 4; ++m) { const int row = u.pm * 256 + ai * 128 + wr * 64 + m * 16 + fr; const unsigned o_ = ((unsigned)row * 128u + wc * 32 + 8 * fq) * 4u;
                wt16f(SST, o_, acc[ai][0][m][0]); wt16f(SST, o_ + 16u, acc[ai][0][m][1]); }
    }
};
struct EpiY {
    static constexpr bool MIDK = false;
    bf16_t* YG;
    __device__ __forceinline__ void operator()(const Acc& acc, const Unit& u, int wr, int wc, int fr, int fq) const {
        asm volatile("" : "+v"(fr), "+v"(fq));
        const int g = u.pm >> 2;
#pragma unroll
        for (int ai = 0; ai < 2; ++ai)
#pragma unroll
            for (int m = 0; m < 4; ++m) { const int R = u.pm * 256 + ai * 128 + wr * 64 + m * 16 + fr, chunk = R & 1023;
#pragma unroll
                for (int bj = 0; bj < 2; ++bj) { const int tt = 8 * bj + 2 * wc + (fq >> 1), cc = 8 * (fq & 1);
                    f32x4 v0 = acc[ai][bj][m][0], v1 = acc[ai][bj][m][1];
#pragma unroll
                    for (int e = 0; e < 4; ++e) { v0[e] = gelu_tanh(v0[e]); v1[e] = gelu_tanh(v1[e]); }
                    *(u32x4*)(YG + (size_t)(chunk * 16 + tt) * 512 + g * 16 + cc) = pack8(v0, v1); } }
    }
};
struct EpiGlu {
    static constexpr bool MIDK = false;
    const bf16_t* YG; bf16_t* MRG; float* STAT;
    __device__ __forceinline__ void operator()(const Acc& acc, const Unit& u, int wr, int wc, int fr, int fq) const {
        asm volatile("" : "+v"(fr), "+v"(fq));
#pragma unroll
        for (int ai = 0; ai < 2; ++ai)
#pragma unroll
            for (int m = 0; m < 4; ++m) { const int row = u.pm * 256 + ai * 128 + wr * 64 + m * 16 + fr; float ss = 0.f;
#pragma unroll
                for (int bj = 0; bj < 2; ++bj) { const int col = u.pn * 256 + bj * 128 + wc * 32 + 8 * fq;
                    const u32x4 yw = *(const u32x4*)(YG + (size_t)row * 512 + col);
                    f32x4 v0 = acc[ai][bj][m][0], v1 = acc[ai][bj][m][1];
                    v0[0] = bflo(yw.x) * sigmoidf_(v0[0]); v0[1] = bfhi(yw.x) * sigmoidf_(v0[1]); v0[2] = bflo(yw.y) * sigmoidf_(v0[2]); v0[3] = bfhi(yw.y) * sigmoidf_(v0[3]);
                    v1[0] = bflo(yw.z) * sigmoidf_(v1[0]); v1[1] = bfhi(yw.z) * sigmoidf_(v1[1]); v1[2] = bflo(yw.w) * sigmoidf_(v1[2]); v1[3] = bfhi(yw.w) * sigmoidf_(v1[3]);
#pragma unroll
                    for (int e = 0; e < 4; ++e) ss += v0[e] * v0[e] + v1[e] * v1[e];
                    *(u32x4*)(MRG + (size_t)row * 1024 + 512 + col) = pack8(v0, v1); }
                ss += __shfl_xor(ss, 16); ss += __shfl_xor(ss, 32);
                if (fq == 0) atomicAdd(STAT + (size_t)row * 2 + 1, ss); }
    }
};
struct EpiOut {
    static constexpr bool MIDK = true;
    const float *xp, *xs, *MOD, *STAT; float* X1;
    __device__ __forceinline__ void mid(Acc& acc, const Unit& u, int wr, int fr) const {
        asm volatile("" : "+v"(fr));
#pragma unroll
        for (int ai = 0; ai < 2; ++ai)
#pragma unroll
            for (int m = 0; m < 4; ++m) { const int row = u.pm * 256 + ai * 128 + wr * 64 + m * 16 + fr;
                const f32x2 st = *(const f32x2*)(STAT + (size_t)row * 2);
                const float ratio = __builtin_amdgcn_rsqf(st[0] * (1.0f / 512.0f) + EPS) * __builtin_sqrtf(st[1] * (1.0f / 512.0f) + EPS);
#pragma unroll
                for (int bj = 0; bj < 2; ++bj) { acc[ai][bj][m][0] = acc[ai][bj][m][0] * ratio; acc[ai][bj][m][1] = acc[ai][bj][m][1] * ratio; } }
    }
    __device__ __forceinline__ void operator()(const Acc& acc, const Unit& u, int wr, int wc, int fr, int fq) const {
        asm volatile("" : "+v"(fr), "+v"(fq));
#pragma unroll
        for (int ai = 0; ai < 2; ++ai)
#pragma unroll
            for (int m = 0; m < 4; ++m) { const int row = u.pm * 256 + ai * 128 + wr * 64 + m * 16 + fr;
                const float* xr = row < MP ? xp + (size_t)row * D : xs + (size_t)(row - MP) * D; const float* gr = MOD + (size_t)mod_row(row) * NMOD + 2048;
                const float rb = __builtin_amdgcn_rsqf(STAT[(size_t)row * 2 + 1] * (1.0f / 512.0f) + EPS);
#pragma unroll
                for (int bj = 0; bj < 2; ++bj) { const int col = u.pn * 256 + bj * 128 + wc * 32 + 8 * fq;
                    const f32x4 x0 = *(const f32x4*)(xr + col), x1 = *(const f32x4*)(xr + col + 4), g0 = *(const f32x4*)(gr + col) * rb, g1 = *(const f32x4*)(gr + col + 4) * rb;
                    if (u.pm >= MP / 256) { const unsigned o_ = ((unsigned)row * D + col) * 4u; wt16f(X1, o_, x0 + g0 * acc[ai][bj][m][0]); wt16f(X1, o_ + 16u, x1 + g1 * acc[ai][bj][m][1]); }
                    else { *(f32x4*)(X1 + (size_t)row * D + col) = x0 + g0 * acc[ai][bj][m][0]; *(f32x4*)(X1 + (size_t)row * D + col + 4) = x1 + g1 * acc[ai][bj][m][1]; } } }
    }
};
struct EpiGU {
    static constexpr bool MIDK = false;
    bf16_t* HB;
    __device__ __forceinline__ void operator()(const Acc& acc, const Unit& u, int wr, int wc, int fr, int fq) const {
        asm volatile("" : "+v"(fr), "+v"(fq));
#pragma unroll
        for (int ai = 0; ai < 2; ++ai)
#pragma unroll
            for (int m = 0; m < 4; ++m) { const int row = u.pm * 256 + ai * 128 + wr * 64 + m * 16 + fr;
                f32x4 v0, v1;
#pragma unroll
                for (int e = 0; e < 4; ++e) { v0[e] = siluf_(acc[ai][0][m][0][e]) * acc[ai][1][m][0][e]; v1[e] = siluf_(acc[ai][0][m][1][e]) * acc[ai][1][m][1][e]; }
                *(u32x4*)(HB + (size_t)row * FF + u.pn * 128 + wc * 32 + 8 * fq) = pack8(v0, v1); }
    }
};
struct EpiDown {
    static constexpr bool MIDK = false;
    const float *X1, *MOD; float* out;
    __device__ __forceinline__ void operator()(const Acc& acc, const Unit& u, int wr, int wc, int fr, int fq) const {
        asm volatile("" : "+v"(fr), "+v"(fq));
#pragma unroll
        for (int ai = 0; ai < 2; ++ai)
#pragma unroll
            for (int m = 0; m < 4; ++m) { const int row = u.pm * 256 + ai * 128 + wr * 64 + m * 16 + fr;
                const float* xr = X1 + (size_t)row * D; const float* gr = MOD + (size_t)mod_row(row) * NMOD + 5120;
                float* orow = row < MP ? out + OFF_Y0 + (size_t)row * D : out + OFF_Y1 + (size_t)(row - MP) * D;
#pragma unroll
                for (int bj = 0; bj < 2; ++bj) { const int col = u.pn * 256 + bj * 128 + wc * 32 + 8 * fq;
                    const f32x4 x0 = *(const f32x4*)(xr + col), x1 = *(const f32x4*)(xr + col + 4), g0 = *(const f32x4*)(gr + col), g1 = *(const f32x4*)(gr + col + 4);
                    *(f32x4*)(orow + col) = x0 + g0 * acc[ai][bj][m][0]; *(f32x4*)(orow + col + 4) = x1 + g1 * acc[ai][bj][m][1]; } }
    }
};

#define XB_TMO      128
#define XB_XCNT(j)  (256  + 64 * (j))
#define XB_XSUB(j)  (1280 + 64 * (j))
#define XB_XGEN(j)  (2304 + 64 * (j))
#define XB_TOP      3328
#define XB_TOPGEN   3392
#define XCD_BAR_WORDS 3456
#define XB_SPIN_CAP (1u << 18)
__device__ __forceinline__ unsigned xb_ld(unsigned* p)              { return __hip_atomic_load(p, __ATOMIC_RELAXED, __HIP_MEMORY_SCOPE_AGENT); }
__device__ __forceinline__ unsigned xb_add(unsigned* p, unsigned v) { return __hip_atomic_fetch_add(p, v, __ATOMIC_RELAXED, __HIP_MEMORY_SCOPE_AGENT); }
__device__ __forceinline__ unsigned xb_xcc_id() { return (unsigned)__builtin_amdgcn_s_getreg((3 << 11) | 20) & 0xFu; }
#define XB_SPIN(cond, bar) do { unsigned _sp = 0; while (cond) { __builtin_amdgcn_s_sleep(1); \
    if ((++_sp & 255u) == 0u) { if (xb_ld(&(bar)[XB_TMO])) break; if (_sp > XB_SPIN_CAP) { atomicAdd(&(bar)[XB_TMO], 1u); break; } } } } while (0)
struct XcdBarrier { unsigned* bar; unsigned x; volatile LAS unsigned* st; };
__device__ __forceinline__ XcdBarrier xcd_barrier_post(unsigned* bar, volatile LAS unsigned* st) {
    XcdBarrier b; b.bar = bar; b.x = xb_xcc_id(); b.st = st;
    if (threadIdx.x == 0) (void)xb_add(&bar[XB_XCNT(b.x)], 1u);
    return b;
}
__device__ __forceinline__ void xcd_barrier_complete(unsigned* bar, unsigned x, unsigned& nloc, unsigned& nx) {
    const unsigned G = gridDim.x * gridDim.y * gridDim.z;
    unsigned sum, cnt, mine, sp = 0u;
    for (;;) {
        sum = 0u; cnt = 0u; mine = 0u;
#pragma unroll
        for (unsigned j = 0; j < 16; ++j) { const unsigned c = xb_ld(&bar[XB_XCNT(j)]); sum += c; cnt += (c > 0u) ? 1u : 0u; mine = (j == x) ? c : mine; }
        if (sum == G) break;
        __builtin_amdgcn_s_sleep(1);
        if ((++sp & 255u) == 0u) { if (xb_ld(&bar[XB_TMO])) break; if (sp > XB_SPIN_CAP) { atomicAdd(&bar[XB_TMO], 1u); break; } }
    }
    nloc = mine > 0u ? mine : 1u; nx = cnt > 0u ? cnt : 1u;
}
__device__ __forceinline__ void xcd_barrier(const XcdBarrier& b) {
    asm volatile("s_waitcnt vmcnt(0)" ::: "memory");
    __syncthreads();
    if (threadIdx.x == 0) {
        unsigned* bar = b.bar;
        __builtin_amdgcn_s_waitcnt(0);
        unsigned nloc = b.st[0], nx = b.st[1];
        if (nloc == 0u) { xcd_barrier_complete(bar, b.x, nloc, nx); b.st[0] = nloc; b.st[1] = nx; }
        const unsigned old = xb_add(&bar[XB_XSUB(b.x)], 1u);
        const unsigned gen = old / nloc;
        if (old + 1u == (gen + 1u) * nloc) {
            __builtin_amdgcn_fence(__ATOMIC_RELEASE, "agent");
            asm volatile("s_waitcnt vmcnt(0)" ::: "memory");
            const unsigned og = xb_add(&bar[XB_TOP], 1u);
            const unsigned tg = og / nx;
            if (og + 1u == (tg + 1u) * nx) xb_add(&bar[XB_TOPGEN], 1u);
            else XB_SPIN(xb_ld(&bar[XB_TOPGEN]) == tg, bar);
            __builtin_amdgcn_fence(__ATOMIC_ACQUIRE, "agent");
            xb_add(&bar[XB_XGEN(b.x)], 1u);
            asm volatile("s_waitcnt vmcnt(0)" ::: "memory");
        } else {
            XB_SPIN(xb_ld(&bar[XB_XGEN(b.x)]) == gen, bar);
            __builtin_amdgcn_fence(__ATOMIC_ACQUIRE, "agent");
            asm volatile("s_waitcnt vmcnt(0)" ::: "memory");
        }
    }
    __syncthreads();
}

struct Args { const float* in[30]; float* out; unsigned char* ws; int ph_lo, ph_hi; };
struct Frame {
    LAS unsigned char* lds; int tid, lane, wave, vcu, G;
};
#define WSP(T, off) ((T*)(A.ws + (off)))

template <class RowMap>
__device__ __forceinline__ void p0_transpose_item(const float* W, int K, int N, bf16_t* WT, const RowMap& rm, LAS float* scr, int item, int lane, const float* kgain = nullptr) {
    const int nblk = N / 32, kb = item / nblk, nb = item % nblk, k0 = 64 * kb, n0 = 32 * nb;
    { const int kq = lane >> 3, nq = lane & 7; f32x4 v[8];
#pragma unroll
      for (int i = 0; i < 8; ++i) v[i] = *(const f32x4*)(W + (size_t)(k0 + 8 * i + kq) * N + n0 + 4 * nq);
#pragma unroll
      for (int i = 0; i < 8; ++i) { LAS float* d = scr + (8 * i + kq) * 33 + 4 * nq; d[0] = v[i][0]; d[1] = v[i][1]; d[2] = v[i][2]; d[3] = v[i][3]; } }
    asm volatile("s_waitcnt lgkmcnt(0)" ::: "memory");
    const int c = lane & 7;
    f32x4 ga = {1.f, 1.f, 1.f, 1.f}, gb = ga;
    if (kgain) { ga = *(const f32x4*)(kgain + k0 + 8 * c); gb = *(const f32x4*)(kgain + k0 + 8 * c + 4); }
#pragma unroll
    for (int j = 0; j < 4; ++j) { const int n = (lane >> 3) + 8 * j; const LAS float* s = scr + (8 * c) * 33 + n;
        u32x4 o; o.x = cvt_pk_bf16(s[0 * 33] * ga[0], s[1 * 33] * ga[1]); o.y = cvt_pk_bf16(s[2 * 33] * ga[2], s[3 * 33] * ga[3]); o.z = cvt_pk_bf16(s[4 * 33] * gb[0], s[5 * 33] * gb[1]); o.w = cvt_pk_bf16(s[6 * 33] * gb[2], s[7 * 33] * gb[3]);
        *(GAS u32x4*)(WT + (size_t)rm(n0 + n) * K + k0 + 8 * c) = o; }
    asm volatile("s_waitcnt lgkmcnt(0)" ::: "memory");
}
struct RmId { __device__ __forceinline__ int operator()(int n) const { return n; } };
struct RmIn { __device__ __forceinline__ int operator()(int F) const { const int f = F & 255; return (F & ~255) + 128 * ((f >> 5) & 1) + 32 * (f >> 6) + (f & 31); } };
struct RmGU { int up; __device__ __forceinline__ int operator()(int h) const { return 256 * (h >> 7) + 128 * up + (h & 127); } };

struct S5n { double dt, lr, li; float cr, ci; };
__device__ __forceinline__ S5n s5_setup(const Args& A, const Frame& F, int g, int n) {
    S5n s; s.dt = (double)expf(A.in[17][g]); s.lr = (double)A.in[15][g * 64 + n]; s.li = (double)A.in[16][g * 64 + n];
    double ar, ai; abar_pow(1.0, s.dt, s.lr, s.li, ar, ai);
    const double nr = ar - 1.0, ni = ai, den = s.lr * s.lr + s.li * s.li;
    s.cr = (float)((nr * s.lr + ni * s.li) / den); s.ci = (float)((ni * s.lr - nr * s.li) / den);
    return s;
}
__device__ __forceinline__ void p0_tmat_task(const Args& A, const Frame& F, int task, LAS float* scr) {
    const int g = task >> 4, c = task & 15, n = F.lane;
    const S5n s = s5_setup(A, F, g, n);
    const float Cr = A.in[20][(g * 16 + c) * 64 + n], Ci = A.in[21][(g * 16 + c) * 64 + n];
    float br[16], bi[16];
#pragma unroll
    for (int cp = 0; cp < 16; ++cp) { const float xr = A.in[18][(g * 64 + n) * 16 + cp], xi = A.in[19][(g * 64 + n) * 16 + cp]; br[cp] = s.cr * xr - s.ci * xi; bi[cp] = s.cr * xi + s.ci * xr; }
    const float dsk = A.in[22][g * 16 + c];
    bf16_t* T = WSP(bf16_t, WS_TMAT) + (size_t)g * 256 * KA;
    double a1r, a1i; abar_pow(1.0, s.dt, s.lr, s.li, a1r, a1i);
    double pr = 1.0, pi = 0.0;
#pragma unroll 1
    for (int j = 0; j < 16; ++j) {
        const float wr_ = (float)pr, wi_ = (float)pi, cwr = Cr * wr_ - Ci * wi_, cwi = Cr * wi_ + Ci * wr_;
#pragma unroll
        for (int cp = 0; cp < 16; ++cp) { float v = wave_sum(cwr * br[cp] - cwi * bi[cp]); if (j == 0 && cp == c) v += dsk; if (n == 0) scr[j * 16 + cp] = v; }
        const double qr = pr * a1r - pi * a1i, qi = pr * a1i + pi * a1r; pr = qr; pi = qi;
        const float q_r = (float)qr, q_i = (float)qi;
        bf16_t* row = T + (size_t)(j * 16 + c) * KA;
        row[256 + n] = (bf16_t)(cvt_pk_bf16(Cr * q_r - Ci * q_i, 0.f) & 0xffffu);
        row[320 + n] = (bf16_t)(cvt_pk_bf16(-(Cr * q_i + Ci * q_r), 0.f) & 0xffffu);
    }
    asm volatile("s_waitcnt lgkmcnt(0)" ::: "memory");
    for (int t = 0; t < 16; ++t) {
        const int sidx = n >> 2, c0 = (n & 3) * 4, j = t - sidx; float v[4];
#pragma unroll
        for (int e = 0; e < 4; ++e) v[e] = (j >= 0) ? scr[(j < 0 ? 0 : j) * 16 + c0 + e] : 0.f;
        u32x2 w; w.x = cvt_pk_bf16(v[0], v[1]); w.y = cvt_pk_bf16(v[2], v[3]);
        *(u32x2*)(T + (size_t)(t * 16 + c) * KA + 4 * n) = w;
    }
    asm volatile("s_waitcnt lgkmcnt(0)" ::: "memory");
}
__device__ __forceinline__ void p0_wend_task(const Args& A, const Frame& F, int task) {
    const int g = task >> 4, sidx = task & 15, n = F.lane;
    const S5n s = s5_setup(A, F, g, n);
    double pr, pi; abar_pow((double)(15 - sidx), s.dt, s.lr, s.li, pr, pi);
    const float wr_ = (float)pr, wi_ = (float)pi;
    float re[16], im[16];
#pragma unroll
    for (int cp = 0; cp < 16; ++cp) { const float xr = A.in[18][(g * 64 + n) * 16 + cp], xi = A.in[19][(g * 64 + n) * 16 + cp]; const float br = s.cr * xr - s.ci * xi, bi = s.cr * xi + s.ci * xr;
        re[cp] = wr_ * br - wi_ * bi; im[cp] = wr_ * bi + wi_ * br; }
    bf16_t* W = WSP(bf16_t, WS_WEND) + (size_t)g * 256 * 256;
    u32x4 a, b;
    a.x = cvt_pk_bf16(re[0], re[1]); a.y = cvt_pk_bf16(re[2], re[3]); a.z = cvt_pk_bf16(re[4], re[5]); a.w = cvt_pk_bf16(re[6], re[7]);
    b.x = cvt_pk_bf16(re[8], re[9]); b.y = cvt_pk_bf16(re[10], re[11]); b.z = cvt_pk_bf16(re[12], re[13]); b.w = cvt_pk_bf16(re[14], re[15]);
    *(u32x4*)(W + (size_t)n * 256 + sidx * 16) = a; *(u32x4*)(W + (size_t)n * 256 + sidx * 16 + 8) = b;
    a.x = cvt_pk_bf16(im[0], im[1]); a.y = cvt_pk_bf16(im[2], im[3]); a.z = cvt_pk_bf16(im[4], im[5]); a.w = cvt_pk_bf16(im[6], im[7]);
    b.x = cvt_pk_bf16(im[8], im[9]); b.y = cvt_pk_bf16(im[10], im[11]); b.z = cvt_pk_bf16(im[12], im[13]); b.w = cvt_pk_bf16(im[14], im[15]);
    *(u32x4*)(W + (size_t)(64 + n) * 256 + sidx * 16) = a; *(u32x4*)(W + (size_t)(64 + n) * 256 + sidx * 16 + 8) = b;
}
__device__ __forceinline__ void p0_prologue(const Args& A, Frame& F) {
    LAS float* scr = (LAS float*)(F.lds + F.wave * 16384);
    for (int i = F.vcu * (NWAVES * 64) + F.tid; i < M * 2 / 4; i += F.G * NWAVES * 64) *(f32x4*)(WSP(float, WS_STAT) + 4 * (size_t)i) = (f32x4){0.f, 0.f, 0.f, 0.f};
    const int gw = F.vcu * NWAVES + F.wave, NGW = F.G * NWAVES;
    constexpr int I_ADA = 16 * 192, I_CS = 256;
    for (int it = gw; it < I_CS + I_ADA; it += NGW) {
        int r = it;
        if (r < I_CS) {
            const float* cr = r < 2 ? A.in[6] + (size_t)r * D : (r < NMODROWS ? A.in[7] + (size_t)(r - 2) * D : nullptr);
            bf16_t* o = WSP(bf16_t, WS_CS) + (size_t)r * D;
#pragma unroll
            for (int j = 0; j < 4; ++j) { f32x4 v = {0.f, 0.f, 0.f, 0.f}; if (cr) { v = *(const f32x4*)(cr + 4 * (F.lane + 64 * j)); v[0] = siluf_(v[0]); v[1] = siluf_(v[1]); v[2] = siluf_(v[2]); v[3] = siluf_(v[3]); }
                u32x2 w; w.x = cvt_pk_bf16(v[0], v[1]); w.y = cvt_pk_bf16(v[2], v[3]); *(u32x2*)(o + 4 * (F.lane + 64 * j)) = w; }
            continue; } r -= I_CS;
        p0_transpose_item(A.in[10], D, NMOD, WSP(bf16_t, WS_WADA), RmId{}, scr, r, F.lane);
    }
}
__device__ __forceinline__ void p1_side_work(const Args& A, Frame& F, int rank, int nranks) {
    LAS float* scr = (LAS float*)(F.lds + F.wave * 16384);
    const int gw = rank * NWAVES + F.wave, NGW = nranks * NWAVES;
    constexpr int I_IN = 16 * 64, I_GLU = 8 * 16, I_OUT = 16 * 32, I_G = 16 * 88, I_DN = 44 * 32, I_TM = 512, I_WE = 512;
    constexpr int NITEMS = I_IN + I_GLU + I_OUT + 2 * I_G + I_DN + I_TM + I_WE;
    for (int it = gw; it < NITEMS; it += NGW) {
        int r = it;
        if (r < I_TM) { p0_tmat_task(A, F, r, scr); continue; } r -= I_TM;
        if (r < I_WE) { p0_wend_task(A, F, r); continue; } r -= I_WE;
        if (r < I_IN) { p0_transpose_item(A.in[12], D, NIN, WSP(bf16_t, WS_WIN), RmIn{}, scr, r, F.lane); continue; } r -= I_IN;
        if (r < I_GLU) { p0_transpose_item(A.in[23], 512, 512, WSP(bf16_t, WS_WGLU), RmId{}, scr, r, F.lane); continue; } r -= I_GLU;
        if (r < I_OUT) { const int kb = r / 32;
            p0_transpose_item(A.in[26], D, D, WSP(bf16_t, WS_WOUT), RmId{}, scr, r, F.lane, kb < 8 ? A.in[24] : A.in[25] - 512); continue; } r -= I_OUT;
        if (r < I_G) { p0_transpose_item(A.in[27], D, FF, WSP(bf16_t, WS_WGU), RmGU{0}, scr, r, F.lane); continue; } r -= I_G;
        if (r < I_G) { p0_transpose_item(A.in[28], D, FF, WSP(bf16_t, WS_WGU), RmGU{1}, scr, r, F.lane); continue; } r -= I_G;
        p0_transpose_item(A.in[29], FF, D, WSP(bf16_t, WS_WDN), RmId{}, scr, r, F.lane);
    }
    { const int gt = rank * (NWAVES * 64) + F.tid, NT = nranks * NWAVES * 64;
      for (int i = gt; i < 32 * 128 * 32; i += NT) { const int g = i >> 12, rem = i & 4095; *(u32x4*)(WSP(bf16_t, WS_WEND) + (size_t)g * 65536 + 128 * 256 + (size_t)rem * 8) = (u32x4){0u, 0u, 0u, 0u}; } }
}

constexpr int CP_NRUN = 2 * 128 * 96, CP_PART = 32, CP_NPART = CP_NRUN / CP_PART;
__device__ __forceinline__ void copy_half_run(const Args& A, int R, int half, int lane) {
    const int tz = R >= 12288 ? 1 : 0, r = R - 12288 * tz, b = r / 96, run = r - 96 * b;
    const size_t off = ((size_t)b * 2048 + 16 * run) * 2048 + (size_t)half * 12288;
    const char* src = (const char*)(tz ? A.in[3] : A.in[2]) + off + 4 * 2048 + lane * 16; char* dst = (char*)(A.out + (tz ? OFF_VS : OFF_KS)) + off + lane * 16;
    u32x4 v[12];
#pragma unroll
    for (int j = 0; j < 12; ++j) v[j] = __builtin_nontemporal_load((const u32x4*)(src + j * 1024));
#pragma unroll
    for (int j = 0; j < 12; ++j) __builtin_nontemporal_store(v[j], (u32x4*)(dst + j * 1024));
}
__device__ __forceinline__ void stream_copy(const Args& A, Frame& F, unsigned* done, unsigned target) {
    LAS int* L = (LAS int*)(F.lds + LDSCTL_OFF);
    unsigned* gctr = (unsigned*)(A.ws + WS_CTL) + CW_CPCTR;
    if (F.tid == 0) L[9] = 0;
    __syncthreads();
    for (;;) {
        if (L[10]) break;
        if (L[0] == 0) {
            __syncthreads();
            if (F.tid == 0) { const unsigned p = __hip_atomic_fetch_add(gctr, 1u, __ATOMIC_RELAXED, __HIP_MEMORY_SCOPE_AGENT); if (p < (unsigned)CP_NPART) L[0] = (int)p + 1; else L[10] = 1; }
            if (F.tid < 8) L[1 + F.tid] = 0;
            __syncthreads();
            if (L[10]) break;
        }
        const int part = __builtin_amdgcn_readfirstlane(L[0]) - 1;
        int c = __builtin_amdgcn_readfirstlane(L[1 + F.wave]);
        while (c < 8) {
            if (done) {
                if (F.wave == 0 && F.lane == 0 && __hip_atomic_load(done + 64 * (F.vcu & 7), __ATOMIC_RELAXED, __HIP_MEMORY_SCOPE_AGENT) >= target) L[9] = 1;
                if (__builtin_amdgcn_readfirstlane(L[9])) break;
            }
            copy_half_run(A, part * CP_PART + F.wave + 8 * (c >> 1), c & 1, F.lane); ++c;
        }
        if (F.lane == 0) L[1 + F.wave] = c;
        if (done && F.wave == 0) {
            for (;;) { bool all = true;
#pragma unroll
                for (int w = 1; w < 8; ++w) all = all && (__builtin_amdgcn_readfirstlane(L[1 + w]) == 8);
                if (all || __builtin_amdgcn_readfirstlane(L[9])) break;
                if (F.lane == 0 && __hip_atomic_load(done + 64 * (F.vcu & 7), __ATOMIC_RELAXED, __HIP_MEMORY_SCOPE_AGENT) >= target) L[9] = 1;
                __builtin_amdgcn_s_sleep(8); }
        }
        __syncthreads();
        if (L[9]) break;
        if (F.tid == 0) L[0] = 0;
        __syncthreads();
    }
    __syncthreads();
}
__device__ __forceinline__ void signal_done(const Args& A, Frame& F, int k) {
    asm volatile("s_waitcnt vmcnt(0)" ::: "memory"); __syncthreads();
    if (F.tid < 8) __hip_atomic_fetch_add((unsigned*)(A.ws + WS_CTL) + CW_DONE + 512 * k + 64 * F.tid, 1u, __ATOMIC_RELAXED, __HIP_MEMORY_SCOPE_AGENT);
}
#define DONE_WORD(k) ((unsigned*)(A.ws + WS_CTL) + CW_DONE + 512 * (k))

__device__ __forceinline__ void wait_done(const Args& A, Frame& F, int k, unsigned target) {
    __syncthreads();
    if (F.tid == 0) { unsigned sp = 0; unsigned* dw = DONE_WORD(k) + 64 * (F.vcu & 7); unsigned* tmo = (unsigned*)(A.ws + WS_CTL) + CW_BAR + XB_TMO;
        while (__hip_atomic_load(dw, __ATOMIC_RELAXED, __HIP_MEMORY_SCOPE_AGENT) < target) { __builtin_amdgcn_s_sleep(2);
            if ((++sp & 255u) == 0u) { if (xb_ld(tmo)) break; if (sp > XB_SPIN_CAP) { atomicAdd(tmo, 1u); break; } } } }
    __syncthreads();
    __builtin_amdgcn_fence(__ATOMIC_ACQUIRE, "agent"); asm volatile("s_waitcnt vmcnt(0)" ::: "memory");
}
__device__ __forceinline__ void norm_mod_pass(const Args& A, Frame& F, const float* xp, const float* xs, const float* gain, int sh_off, int sc_off, bf16_t* XN, int row0, int row1, int gw, int NGW, const bool wthru = false) {
    const float* MOD = WSP(float, WS_MOD);
    for (int row = row0 + gw; row < row1; row += NGW) {
        const float* xr = row < MP ? xp + (size_t)row * D : xs + (size_t)(row - MP) * D; const float* mr = MOD + (size_t)mod_row(row) * NMOD;
        f32x4 v[4]; float s = 0.f;
#pragma unroll
        for (int j = 0; j < 4; ++j) { v[j] = *(const f32x4*)(xr + 4 * (F.lane + 64 * j)); s += (v[j][0] * v[j][0] + v[j][1] * v[j][1]) + (v[j][2] * v[j][2] + v[j][3] * v[j][3]); }
        const float rs = __builtin_amdgcn_rsqf(wave_sum(s) * (1.0f / D) + EPS);
#pragma unroll
        for (int j = 0; j < 4; ++j) { const int col = 4 * (F.lane + 64 * j);
            const f32x4 g = *(const f32x4*)(gain + col), sc = *(const f32x4*)(mr + sc_off + col), sh = *(const f32x4*)(mr + sh_off + col);
            const f32x4 h = v[j] * rs * g * (sc + 1.0f) + sh;
            u32x2 w; w.x = cvt_pk_bf16(h[0], h[1]); w.y = cvt_pk_bf16(h[2], h[3]);
            if (wthru) __builtin_amdgcn_raw_buffer_store_b64(w, __builtin_amdgcn_make_buffer_rsrc((void*)XN, 0, 0xffffffffu, 0x00020000), (int)(((unsigned)row * D + col) * 2u), 0, 16);
            else *(u32x2*)(XN + (size_t)row * D + col) = w; }
    }
}
__device__ __forceinline__ void merged_norm_pass(const Args& A, Frame& F) {
    const int gw = F.vcu * NWAVES + F.wave, NGW = F.G * NWAVES; const bf16_t* MRG = WSP(bf16_t, WS_MRG); bf16_t* O = WSP(bf16_t, WS_XN);
    for (int row = gw; row < M; row += NGW) {
        const u32x4 a = *(const u32x4*)(MRG + (size_t)row * D + 8 * F.lane), b = *(const u32x4*)(MRG + (size_t)row * D + 512 + 8 * F.lane);
        float av[8] = {bflo(a.x), bfhi(a.x), bflo(a.y), bfhi(a.y), bflo(a.z), bfhi(a.z), bflo(a.w), bfhi(a.w)};
        float bv[8] = {bflo(b.x), bfhi(b.x), bflo(b.y), bfhi(b.y), bflo(b.z), bfhi(b.z), bflo(b.w), bfhi(b.w)};
        float sa = 0.f, sb = 0.f;
#pragma unroll
        for (int e = 0; e < 8; ++e) { sa += av[e] * av[e]; sb += bv[e] * bv[e]; }
        const float ra = __builtin_amdgcn_rsqf(wave_sum(sa) * (1.0f / 512.0f) + EPS), rb = __builtin_amdgcn_rsqf(wave_sum(sb) * (1.0f / 512.0f) + EPS);
        const float* ga = A.in[24] + 8 * F.lane; const float* gs = A.in[25] + 8 * F.lane;
        const f32x4 ga0 = *(const f32x4*)ga, ga1 = *(const f32x4*)(ga + 4), gs0 = *(const f32x4*)gs, gs1 = *(const f32x4*)(gs + 4);
        u32x4 oa, ob;
        oa.x = cvt_pk_bf16(av[0] * ra * ga0[0], av[1] * ra * ga0[1]); oa.y = cvt_pk_bf16(av[2] * ra * ga0[2], av[3] * ra * ga0[3]);
        oa.z = cvt_pk_bf16(av[4] * ra * ga1[0], av[5] * ra * ga1[1]); oa.w = cvt_pk_bf16(av[6] * ra * ga1[2], av[7] * ra * ga1[3]);
        ob.x = cvt_pk_bf16(bv[0] * rb * gs0[0], bv[1] * rb * gs0[1]); ob.y = cvt_pk_bf16(bv[2] * rb * gs0[2], bv[3] * rb * gs0[3]);
        ob.z = cvt_pk_bf16(bv[4] * rb * gs1[0], bv[5] * rb * gs1[1]); ob.w = cvt_pk_bf16(bv[6] * rb * gs1[2], bv[7] * rb * gs1[3]);
        *(u32x4*)(O + (size_t)row * D + 8 * F.lane) = oa; *(u32x4*)(O + (size_t)row * D + 512 + 8 * F.lane) = ob;
    }
}

constexpr float NEGBIG = -1.0e30f;
constexpr int VROWB = 144;
constexpr int AT_ACC_OFF = 40960, AT_PITCH = 68, AT_L_OFF = AT_ACC_OFF + 256 * AT_PITCH * 4;
__device__ __forceinline__ s16x4 vtr(const LAS unsigned char* p) { typedef short v4i16_t __attribute__((ext_vector_type(4))); return __builtin_bit_cast(s16x4, __builtin_amdgcn_ds_read_tr16_b64_v4i16((LAS v4i16_t*)p)); }
struct AttnAcc { f32x4 O[4]; float l; };
__device__ __forceinline__ void attn_load_q(const bf16_t* Qb, size_t rowb, int h, int tq, float kmax, bf16x8 (&qf)[2], float& cshift, int lane) {
    const int g = lane >> 4;
    const bf16_t* qp = Qb + (rowb + tq) * 512 + h * 64 + 8 * g; qf[0] = *(const bf16x8*)qp; qf[1] = *(const bf16x8*)(qp + 32);
    float ss = 0.f;
#pragma unroll
    for (int e = 0; e < 8; ++e) { const float x = bf2f((unsigned short)qf[0][e]), y = bf2f((unsigned short)qf[1][e]); ss += x * x + y * y; }
    ss += __shfl_xor(ss, 16); ss += __shfl_xor(ss, 32);
    cshift = __builtin_sqrtf(ss) * kmax;
}
__device__ __forceinline__ void attn_blocks(const bf16_t* Kb, const bf16_t* Vb, size_t rowb, int h, const bf16x8 (&qf)[2], float cshift, AttnAcc& acc, int T0, int dil, int sq, int nblk, LAS unsigned char* vlds, int lane) {
    const int iq = lane & 15, g = lane >> 4, vrow = lane >> 3, vch = lane & 7;
    const LAS unsigned char* vrd = vlds + (4 * g + (iq >> 2)) * VROWB + (iq & 3) * 8;
    const int jjmin = -(T0 / dil);
    int ddmax = sq * iq - jjmin; ddmax = ddmax > 128 ? 128 : ddmax;
    const f32x4 cinit = {-cshift, -cshift, -cshift, -cshift};
#pragma unroll 1
    for (int kb = 0; kb < nblk; ++kb) {
        const int jj0 = -128 + 32 * kb;
        if (T0 + dil * (jj0 + 31) < 0) continue;
        bf16x8 kf[2][2];
#pragma unroll
        for (int tl = 0; tl < 2; ++tl) { int tok = T0 + dil * (jj0 + 16 * tl + iq); tok = tok < 0 ? 0 : (tok > SEQ - 1 ? SEQ - 1 : tok);
            const bf16_t* kp = Kb + (rowb + tok) * 512 + h * 64 + 8 * g; kf[tl][0] = *(const bf16x8*)kp; kf[tl][1] = *(const bf16x8*)(kp + 32); }
        u32x4 vreg[4];
#pragma unroll
        for (int rep = 0; rep < 4; ++rep) { int tok = T0 + dil * (jj0 + vrow + 8 * rep); tok = tok < 0 ? 0 : (tok > SEQ - 1 ? SEQ - 1 : tok);
            vreg[rep] = *(const u32x4*)(Vb + (rowb + tok) * 512 + h * 64 + 8 * vch); }
        f32x4 st[2];
#pragma unroll
        for (int tl = 0; tl < 2; ++tl) { st[tl] = __builtin_amdgcn_mfma_f32_16x16x32_bf16(kf[tl][0], qf[0], cinit, 0, 0, 0);
            st[tl] = __builtin_amdgcn_mfma_f32_16x16x32_bf16(kf[tl][1], qf[1], st[tl], 0, 0, 0); }
#pragma unroll
        for (int rep = 0; rep < 4; ++rep) *(LAS u32x4*)(vlds + (vrow + 8 * rep) * VROWB + vch * 16) = vreg[rep];
        const int base = sq * iq - 4 * g - jj0; float p[8]; float ps = 0.f;
#pragma unroll
        for (int j = 0; j < 8; ++j) { const int dd = base - (16 * (j >> 2) + (j & 3)); p[j] = ((unsigned)dd <= (unsigned)ddmax) ? fexp2(st[j >> 2][j & 3]) : 0.f; ps += p[j]; }
        acc.l += ps;
        bf16x8 pf; { u32x4 w; w.x = cvt_pk_bf16(p[0], p[1]); w.y = cvt_pk_bf16(p[2], p[3]); w.z = cvt_pk_bf16(p[4], p[5]); w.w = cvt_pk_bf16(p[6], p[7]); pf = __builtin_bit_cast(bf16x8, w); }
        asm volatile("s_waitcnt lgkmcnt(0)" ::: "memory");
#pragma unroll
        for (int d = 0; d < 4; ++d) {
            const s16x4 lo = vtr(vrd + d * 32), hi = vtr(vrd + d * 32 + 16 * VROWB);
            const bf16x8 vf = (bf16x8){lo[0], lo[1], lo[2], lo[3], hi[0], hi[1], hi[2], hi[3]};
            acc.O[d] = __builtin_amdgcn_mfma_f32_16x16x32_bf16(vf, pf, acc.O[d], 0, 0, 0);
        }
        asm volatile("s_waitcnt lgkmcnt(0)" ::: "memory");
    }
}
template <int DIL, int SQ, int NBLK, int OFFB>
__device__ __forceinline__ void attn_blocks2(const bf16_t* Kb, const bf16_t* Vb, size_t rowb, int h, const bf16x8 (&qfA)[2], float csA, AttnAcc& accA, const bf16x8 (&qfB)[2], float csB, AttnAcc& accB,
                                             int T0, LAS unsigned char* vlds, int lane) {
    const int iq = lane & 15, g = lane >> 4, vrow = lane >> 3, vch = lane & 7;
    const LAS unsigned char* vrd = vlds + (4 * g + (iq >> 2)) * VROWB + (iq & 3) * 8;
    const int jjmin = -(T0 / DIL);
    int ddmaxA = SQ * iq - jjmin; ddmaxA = ddmaxA > 128 ? 128 : ddmaxA;
    int ddmaxB = SQ * iq + OFFB - jjmin; ddmaxB = ddmaxB > 128 ? 128 : ddmaxB;
    const f32x4 cinitA = {-csA, -csA, -csA, -csA}, cinitB = {-csB, -csB, -csB, -csB};
#pragma unroll 1
    for (int kb = 0; kb < NBLK; ++kb) {
        const int jj0 = -128 + 32 * kb;
        if (T0 + DIL * (jj0 + 31) < 0) continue;
        bf16x8 kf[2][2];
#pragma unroll
        for (int tl = 0; tl < 2; ++tl) { int tok = T0 + DIL * (jj0 + 16 * tl + iq); tok = tok < 0 ? 0 : (tok > SEQ - 1 ? SEQ - 1 : tok);
            const bf16_t* kp = Kb + (rowb + tok) * 512 + h * 64 + 8 * g; kf[tl][0] = *(const bf16x8*)kp; kf[tl][1] = *(const bf16x8*)(kp + 32); }
        u32x4 vreg[4];
#pragma unroll
        for (int rep = 0; rep < 4; ++rep) { int tok = T0 + DIL * (jj0 + vrow + 8 * rep); tok = tok < 0 ? 0 : (tok > SEQ - 1 ? SEQ - 1 : tok);
            vreg[rep] = *(const u32x4*)(Vb + (rowb + tok) * 512 + h * 64 + 8 * vch); }
        f32x4 stA[2], stB[2];
#pragma unroll
        for (int tl = 0; tl < 2; ++tl) {
            stA[tl] = __builtin_amdgcn_mfma_f32_16x16x32_bf16(kf[tl][0], qfA[0], cinitA, 0, 0, 0); stA[tl] = __builtin_amdgcn_mfma_f32_16x16x32_bf16(kf[tl][1], qfA[1], stA[tl], 0, 0, 0);
            stB[tl] = __builtin_amdgcn_mfma_f32_16x16x32_bf16(kf[tl][0], qfB[0], cinitB, 0, 0, 0); stB[tl] = __builtin_amdgcn_mfma_f32_16x16x32_bf16(kf[tl][1], qfB[1], stB[tl], 0, 0, 0); }
#pragma unroll
        for (int rep = 0; rep < 4; ++rep) *(LAS u32x4*)(vlds + (vrow + 8 * rep) * VROWB + vch * 16) = vreg[rep];
        const int base = SQ * iq - 4 * g - jj0; float pA[8], pB[8]; float psA = 0.f, psB = 0.f;
#pragma unroll
        for (int j = 0; j < 8; ++j) { const int dd = base - (16 * (j >> 2) + (j & 3));
            pA[j] = ((unsigned)dd <= (unsigned)ddmaxA) ? fexp2(stA[j >> 2][j & 3]) : 0.f; psA += pA[j];
            pB[j] = ((unsigned)(dd + OFFB) <= (unsigned)ddmaxB) ? fexp2(stB[j >> 2][j & 3]) : 0.f; psB += pB[j]; }
        accA.l += psA; accB.l += psB;
        bf16x8 pfA, pfB;
        { u32x4 w; w.x = cvt_pk_bf16(pA[0], pA[1]); w.y = cvt_pk_bf16(pA[2], pA[3]); w.z = cvt_pk_bf16(pA[4], pA[5]); w.w = cvt_pk_bf16(pA[6], pA[7]); pfA = __builtin_bit_cast(bf16x8, w); }
        { u32x4 w; w.x = cvt_pk_bf16(pB[0], pB[1]); w.y = cvt_pk_bf16(pB[2], pB[3]); w.z = cvt_pk_bf16(pB[4], pB[5]); w.w = cvt_pk_bf16(pB[6], pB[7]); pfB = __builtin_bit_cast(bf16x8, w); }
        asm volatile("s_waitcnt lgkmcnt(0)" ::: "memory");
#pragma unroll
        for (int d = 0; d < 4; ++d) {
            const s16x4 lo = vtr(vrd + d * 32), hi = vtr(vrd + d * 32 + 16 * VROWB);
            const bf16x8 vf = (bf16x8){lo[0], lo[1], lo[2], lo[3], hi[0], hi[1], hi[2], hi[3]};
            accA.O[d] = __builtin_amdgcn_mfma_f32_16x16x32_bf16(vf, pfA, accA.O[d], 0, 0, 0);
            accB.O[d] = __builtin_amdgcn_mfma_f32_16x16x32_bf16(vf, pfB, accB.O[d], 0, 0, 0);
        }
        asm volatile("s_waitcnt lgkmcnt(0)" ::: "memory");
    }
}
__device__ __forceinline__ void prompt_attention(const Args& A, Frame& F, const int u0, const int du, const int nu, const int uextra) {
    const bf16_t* Qb = WSP(bf16_t, WS_Q); const bf16_t* Kb = WSP(bf16_t, WS_K); const bf16_t* Vb = WSP(bf16_t, WS_V); bf16_t* MRG = WSP(bf16_t, WS_MRG); float* STAT = WSP(float, WS_STAT);
    LAS unsigned char* vlds = F.lds + F.wave * 4608;
    LAS float* accl = (LAS float*)(F.lds + AT_ACC_OFF); LAS float* lacc = (LAS float*)(F.lds + AT_L_OFF);
    const int lane = F.lane, iq = lane & 15, g = lane >> 4;
    float kmax; { float x = fabsf(A.in[14][lane]);
#pragma unroll
        for (int o = 1; o < 64; o <<= 1) x = fmaxf(x, __shfl_xor(x, o));
        kmax = x * 8.0f * 1.01f; }
    for (int ku = 0; ku < nu + (uextra >= 0 ? 1 : 0); ++ku) {
        const int uu = ku < nu ? u0 + du * ku : uextra;
        const int blk = uu & 31, h = (uu >> 5) & 7, b = uu >> 8, Tb = blk * 256; const size_t rowb = (size_t)b * SEQ;
        { const int a = 2 * F.wave, TA = Tb + 16 * a;
            bf16x8 qfA[2], qfB[2]; float csA, csB; attn_load_q(Qb, rowb, h, TA + iq, kmax, qfA, csA, lane); attn_load_q(Qb, rowb, h, TA + 16 + iq, kmax, qfB, csB, lane);
            AttnAcc accA, accB; accA.l = 0.f; accB.l = 0.f;
#pragma unroll
            for (int d = 0; d < 4; ++d) { accA.O[d] = (f32x4){0.f, 0.f, 0.f, 0.f}; accB.O[d] = (f32x4){0.f, 0.f, 0.f, 0.f}; }
            attn_blocks2<1, 1, 6, 16>(Kb, Vb, rowb, h, qfA, csA, accA, qfB, csB, accB, TA, vlds, lane);
            float lA = accA.l, lB = accB.l; lA += __shfl_xor(lA, 16); lA += __shfl_xor(lA, 32); lB += __shfl_xor(lB, 16); lB += __shfl_xor(lB, 32);
            LAS float* ap = accl + (16 * a + iq) * AT_PITCH + 4 * g;
#pragma unroll
            for (int d = 0; d < 4; ++d) { *(LAS f32x4*)(ap + 16 * d) = accA.O[d]; *(LAS f32x4*)(ap + 16 * AT_PITCH + 16 * d) = accB.O[d]; }
            if (g == 0) { lacc[16 * a + iq] = lA; lacc[16 * a + 16 + iq] = lB; }
        }
        __syncthreads();
        { const int r = F.wave;
            bf16x8 qfA[2], qfB[2]; float csA, csB; attn_load_q(Qb, rowb, h, Tb + r + 16 * iq, kmax, qfA, csA, lane); attn_load_q(Qb, rowb, h, Tb + r + 8 + 16 * iq, kmax, qfB, csB, lane);
            AttnAcc accA, accB; accA.l = 0.f; accB.l = 0.f;
#pragma unroll
            for (int d = 0; d < 4; ++d) { accA.O[d] = (f32x4){0.f, 0.f, 0.f, 0.f}; accB.O[d] = (f32x4){0.f, 0.f, 0.f, 0.f}; }
            attn_blocks2<4, 4, 6, 2>(Kb, Vb, rowb, h, qfA, csA, accA, qfB, csB, accB, Tb + r, vlds, lane);
            attn_blocks(Kb, Vb, rowb, h, qfA, csA, accA, Tb + r, 16, 1, 5, vlds, lane);
            attn_blocks(Kb, Vb, rowb, h, qfB, csB, accB, Tb + r + 8, 16, 1, 5, vlds, lane);
            float lA = accA.l, lB = accB.l; lA += __shfl_xor(lA, 16); lA += __shfl_xor(lA, 32); lB += __shfl_xor(lB, 16); lB += __shfl_xor(lB, 32);
            LAS float* ap = accl + (r + 16 * iq) * AT_PITCH + 4 * g;
#pragma unroll
            for (int d = 0; d < 4; ++d) { const f32x4 o = *(LAS f32x4*)(ap + 16 * d); *(LAS f32x4*)(ap + 16 * d) = o + accA.O[d];
                const f32x4 o2 = *(LAS f32x4*)(ap + 8 * AT_PITCH + 16 * d); *(LAS f32x4*)(ap + 8 * AT_PITCH + 16 * d) = o2 + accB.O[d]; }
            if (g == 0) { lacc[r + 16 * iq] += lA; lacc[r + 8 + 16 * iq] += lB; }
        }
        __syncthreads();
        { const int q = F.tid >> 1, half = F.tid & 1; const float inv = 1.0f / lacc[q]; const LAS float* ap = accl + q * AT_PITCH + 32 * half;
          bf16_t* op = MRG + (rowb + Tb + q) * 1024 + h * 64 + 32 * half; float ss = 0.f;
#pragma unroll
          for (int kk = 0; kk < 4; ++kk) { const f32x4 x = *(const LAS f32x4*)(ap + 8 * kk) * inv, y = *(const LAS f32x4*)(ap + 8 * kk + 4) * inv; *(u32x4*)(op + 8 * kk) = pack8(x, y);
#pragma unroll
              for (int e = 0; e < 4; ++e) ss += x[e] * x[e] + y[e] * y[e]; }
          ss += dpp_mov<0xB1>(ss);
          if (half == 0) atomicAdd(STAT + (rowb + Tb + q) * 2, ss); }
        __syncthreads();
    }
}

struct SAState { float m[4], l[4]; f32x4 o[4]; };
__device__ __forceinline__ float red16(float v) { return row16_sum(v); }
__device__ __forceinline__ void sa_accum(SAState& S, int t, float s, float mult, const f32x4& v) {
    const float mnew = fmaxf(S.m[t], s), alpha = fexp2(S.m[t] - mnew), pw = mult * fexp2(s - mnew);
    S.l[t] = S.l[t] * alpha + pw; S.o[t] = S.o[t] * alpha + v * pw; S.m[t] = mnew;
}
__device__ __forceinline__ void sample_attention(const Args& A, Frame& F, const int maxu) {
    const float* QS = WSP(float, WS_QS); bf16_t* MRG = WSP(bf16_t, WS_MRG);
    LAS float* mg = (LAS float*)F.lds;
    LAS int* QL = (LAS int*)(F.lds + LDSCTL_OFF);
    for (int nu_ = 0; nu_ < maxu; ++nu_) {
        if (F.tid == 0) QL[16] = (int)__hip_atomic_fetch_add((unsigned*)(A.ws + WS_CTL) + CW_QS, 1u, __ATOMIC_RELAXED, __HIP_MEMORY_SCOPE_AGENT);
        __syncthreads();
        const int uu = __builtin_amdgcn_readfirstlane(QL[16]);
        if (uu >= 256) break;
        const int bs = uu >> 1, hh = uu & 1, hl = F.lane >> 4, head = 4 * hh + hl, dq = 4 * (F.lane & 15);
        const int coff = head * 64 + dq;
        f32x4 q[4];
#pragma unroll
        for (int t = 0; t < 4; ++t) q[t] = *(const f32x4*)(QS + (size_t)(bs * 4 + t) * 512 + coff);
        SAState S;
#pragma unroll
        for (int t = 0; t < 4; ++t) { S.m[t] = NEGBIG; S.l[t] = 0.f; S.o[t] = (f32x4){0.f, 0.f, 0.f, 0.f}; }
        const float* ck = A.in[2] + (size_t)bs * KVB * 512 + coff; const float* cv = A.in[3] + (size_t)bs * KVB * 512 + coff;
        const float* nk = A.out + OFF_KS + ((size_t)bs * KVB + (KVB - 4)) * 512 + coff; const float* nv = A.out + OFF_VS + ((size_t)bs * KVB + (KVB - 4)) * 512 + coff;
        float* dk = A.out + OFF_KS + (size_t)bs * KVB * 512 + coff; float* dv = A.out + OFF_VS + (size_t)bs * KVB * 512 + coff;
        f32x4 ka[8], va[8], kb[8], vb[8];
#define SA_LOAD_A(i0_, KK, VV) do { _Pragma("unroll") for (int j = 0; j < 8; ++j) { int p = 1536 + F.wave + 8 * ((i0_) + j); if (p > 2051) p = 2051; \
                KK[j] = p < KVB ? *(const f32x4*)(ck + (size_t)p * 512) : *(const f32x4*)(nk + (size_t)(p - KVB) * 512); \
                VV[j] = p < KVB ? *(const f32x4*)(cv + (size_t)p * 512) : *(const f32x4*)(nv + (size_t)(p - KVB) * 512); } } while (0)
#define SA_PROC_A(i0_, KK, VV) do { \
            _Pragma("unroll") for (int j = 0; j < 8; ++j) { const int p = 1536 + F.wave + 8 * ((i0_) + j); if (p < KVB) { __builtin_nontemporal_store(KK[j], (f32x4*)(dk + (size_t)(p - 4) * 512)); __builtin_nontemporal_store(VV[j], (f32x4*)(dv + (size_t)(p - 4) * 512)); } } \
            _Pragma("unroll") for (int j = 0; j < 8; ++j) { const int p = 1536 + F.wave + 8 * ((i0_) + j); if (p <= 2051) { \
                _Pragma("unroll") for (int t = 0; t < 4; ++t) { const int dist = KVB + t - p; \
                    if (dist >= 0) { const int mult = (dist <= 128 ? 1 : 0) + (((dist & 3) == 0 && dist <= 512) ? 1 : 0) + ((dist & 15) == 0 ? 1 : 0); \
                        if (mult > 0) { const float s = red16(q[t][0] * KK[j][0] + q[t][1] * KK[j][1] + q[t][2] * KK[j][2] + q[t][3] * KK[j][3]); sa_accum(S, t, s, (float)mult, VV[j]); } } } } } } while (0)
        SA_LOAD_A(0, ka, va);
#pragma unroll 1
        for (int i0 = 0; i0 < 72; i0 += 16) {
            if (i0 + 8 < 72) SA_LOAD_A(i0 + 8, kb, vb);
            SA_PROC_A(i0, ka, va);
            if (i0 + 16 < 72) SA_LOAD_A(i0 + 16, ka, va);
            if (i0 + 8 < 72) SA_PROC_A(i0 + 8, kb, vb);
        }
#define SA_LOAD_B(i0_, KK, VV) do { _Pragma("unroll") for (int j = 0; j < 8; ++j) { const int idx = F.wave + 8 * ((i0_) + j), p = 16 * (idx >> 2) + (idx & 3); \
                KK[j] = *(const f32x4*)(ck + (size_t)p * 512); VV[j] = *(const f32x4*)(cv + (size_t)p * 512); } } while (0)
#define SA_PROC_B(i0_, KK, VV) do { \
            _Pragma("unroll") for (int j = 0; j < 8; ++j) { const int idx = F.wave + 8 * ((i0_) + j), p = 16 * (idx >> 2) + (idx & 3); \
                if (p >= 4) { __builtin_nontemporal_store(KK[j], (f32x4*)(dk + (size_t)(p - 4) * 512)); __builtin_nontemporal_store(VV[j], (f32x4*)(dv + (size_t)(p - 4) * 512)); } } \
            _Pragma("unroll") for (int j = 0; j < 8; ++j) { const int t = (F.wave + 8 * ((i0_) + j)) & 3;      \
                float s0 = 0.f; \
                _Pragma("unroll") for (int tt = 0; tt < 4; ++tt) if (tt == t) s0 = q[tt][0] * KK[j][0] + q[tt][1] * KK[j][1] + q[tt][2] * KK[j][2] + q[tt][3] * KK[j][3]; \
                const float s = red16(s0); \
                _Pragma("unroll") for (int tt = 0; tt < 4; ++tt) if (tt == t) sa_accum(S, tt, s, 1.0f, VV[j]); } } while (0)
        SA_LOAD_B(0, ka, va);
#pragma unroll 1
        for (int i0 = 0; i0 < 48; i0 += 16) {
            SA_LOAD_B(i0 + 8, kb, vb);
            SA_PROC_B(i0, ka, va);
            if (i0 + 16 < 48) SA_LOAD_B(i0 + 16, ka, va);
            SA_PROC_B(i0 + 8, kb, vb);
        }
#undef SA_LOAD_A
#undef SA_PROC_A
#undef SA_LOAD_B
#undef SA_PROC_B
#pragma unroll
        for (int t = 0; t < 4; ++t) { LAS float* p = mg + ((F.wave * 4 + t) * 6) * 64 + F.lane; p[0] = S.m[t]; p[64] = S.l[t]; p[128] = S.o[t][0]; p[192] = S.o[t][1]; p[256] = S.o[t][2]; p[320] = S.o[t][3]; }
        __syncthreads();
        if (F.wave < 4) { const int t = F.wave; float mm = NEGBIG;
#pragma unroll
            for (int w = 0; w < 8; ++w) mm = fmaxf(mm, mg[((w * 4 + t) * 6) * 64 + F.lane]);
            float L = 0.f; f32x4 o = {0.f, 0.f, 0.f, 0.f};
#pragma unroll
            for (int w = 0; w < 8; ++w) { const LAS float* p = mg + ((w * 4 + t) * 6) * 64 + F.lane; const float f = fexp2(p[0] - mm); L += p[64] * f; o[0] += p[128] * f; o[1] += p[192] * f; o[2] += p[256] * f; o[3] += p[320] * f; }
            const float inv = 1.0f / L; u32x2 w2; w2.x = cvt_pk_bf16(o[0] * inv, o[1] * inv); w2.y = cvt_pk_bf16(o[2] * inv, o[3] * inv);
            *(u32x2*)(MRG + (size_t)(MP + bs * 4 + t) * 1024 + coff) = w2;
            const float ss = row16_sum((o[0] * o[0] + o[1] * o[1] + o[2] * o[2] + o[3] * o[3]) * inv * inv);
            if ((F.lane & 15) == 0) atomicAdd(WSP(float, WS_STAT) + (size_t)(MP + bs * 4 + t) * 2, ss); }
        __syncthreads();
    }
}

__device__ __forceinline__ void sample_s5(const Args& A, Frame& F) {
    const int gw = F.vcu * NWAVES + F.wave, NGW = F.G * NWAVES, n = F.lane; const float* US = WSP(float, WS_US); bf16_t* YG = WSP(bf16_t, WS_YG);
    for (int task = gw; task < 128 * 32; task += NGW) {
        const int bs = task >> 5, g = task & 31;
        const S5n s = s5_setup(A, F, g, n);
        double ar, ai; abar_pow(1.0, s.dt, s.lr, s.li, ar, ai); const float a_r = (float)ar, a_i = (float)ai;
        float hr = A.in[4][((size_t)bs * 32 + g) * 64 + n], hi = A.in[5][((size_t)bs * 32 + g) * 64 + n];
        const float uval = US[(size_t)(bs * 4 + (n >> 4)) * 512 + g * 16 + (n & 15)];
        float yv = 0.f;
#pragma unroll 1
        for (int t = 0; t < 4; ++t) {
            float bur = 0.f, bui = 0.f;
#pragma unroll
            for (int c = 0; c < 16; ++c) { const float u = rdlane(uval, t * 16 + c); const float xr = A.in[18][(g * 64 + n) * 16 + c], xi = A.in[19][(g * 64 + n) * 16 + c];
                bur += (s.cr * xr - s.ci * xi) * u; bui += (s.cr * xi + s.ci * xr) * u; }
            const float nr = a_r * hr - a_i * hi + bur, ni = a_r * hi + a_i * hr + bui; hr = nr; hi = ni;
#pragma unroll
            for (int c = 0; c < 16; ++c) { const float Cr = A.in[20][(g * 16 + c) * 64 + n], Ci = A.in[21][(g * 16 + c) * 64 + n];
                float y = wave_sum(Cr * hr - Ci * hi) + A.in[22][g * 16 + c] * rdlane(uval, t * 16 + c);
                y = gelu_tanh(y); if (n == t * 16 + c) yv = y; }
        }
        YG[(size_t)(MP + bs * 4 + (n >> 4)) * 512 + g * 16 + (n & 15)] = (bf16_t)(cvt_pk_bf16(yv, 0.f) & 0xffffu);
        A.out[OFF_HRS + ((size_t)bs * 32 + g) * 64 + n] = hr; A.out[OFF_HIS + ((size_t)bs * 32 + g) * 64 + n] = hi;
    }
}

__device__ __forceinline__ void s5_carry(const Args& A, Frame& F, const int b, const int g) {
    const int n = F.lane, w = F.wave;
    const S5n s = s5_setup(A, F, g, n);
    double ar, ai; abar_pow(16.0, s.dt, s.lr, s.li, ar, ai); const float a_r = (float)ar, a_i = (float)ai;
    double pr = ar, pi = ai;
#pragma unroll
    for (int k = 0; k < 6; ++k) { const double qr = pr * pr - pi * pi, qi = 2.0 * pr * pi; pr = qr; pi = qi; }
    const float A_r = (float)pr, A_i = (float)pi;
    bf16_t* AP = WSP(bf16_t, WS_AP); const float* SST = WSP(float, WS_SST);
    const size_t row0 = (size_t)g * 1024 + (size_t)b * 512 + (size_t)w * 64;
    float sr[64], si[64];
#pragma unroll
    for (int c = 0; c < 64; ++c) { sr[c] = SST[(row0 + c) * 128 + n]; si[c] = SST[(row0 + c) * 128 + 64 + n]; }
    float er = 0.f, ei = 0.f;
#pragma unroll
    for (int c = 0; c < 64; ++c) { const float nr = a_r * er - a_i * ei + sr[c], ni = a_r * ei + a_i * er + si[c]; er = nr; ei = ni; }
    LAS float* X = (LAS float*)F.lds;
    X[(w * 2) * 64 + n] = er; X[(w * 2 + 1) * 64 + n] = ei;
    __syncthreads();
    float hr = 0.f, hi = 0.f;
#pragma unroll
    for (int j = 0; j < 7; ++j) if (j < w) { const float xr = X[(j * 2) * 64 + n], xi = X[(j * 2 + 1) * 64 + n]; const float nr = A_r * hr - A_i * hi + xr, ni = A_r * hi + A_i * hr + xi; hr = nr; hi = ni; }
#pragma unroll
    for (int c = 0; c < 64; ++c) {
        AP[(row0 + c) * KA + 256 + n] = (bf16_t)(cvt_pk_bf16(hr, 0.f) & 0xffffu); AP[(row0 + c) * KA + 320 + n] = (bf16_t)(cvt_pk_bf16(hi, 0.f) & 0xffffu);
        const float nr = a_r * hr - a_i * hi + sr[c], ni = a_r * hi + a_i * hr + si[c]; hr = nr; hi = ni;
    }
    if (w == 7) { A.out[OFF_HRP + ((size_t)b * 32 + g) * 64 + n] = hr; A.out[OFF_HIP + ((size_t)b * 32 + g) * 64 + n] = hi; }
    __syncthreads();
}

constexpr int NPHASE = 13;
__global__ void __launch_bounds__(NWAVES * 64, 2) mk_fwd(Args args) {
    const Args& A = args;
    extern __shared__ __attribute__((aligned(16))) unsigned char lds_raw[];
    Frame F;
    F.lds = (LAS unsigned char*)lds_raw;
    F.tid = threadIdx.x; F.lane = F.tid & 63; F.wave = __builtin_amdgcn_readfirstlane(F.tid >> 6);
    F.G = gridDim.x; { const int bx = blockIdx.x; F.vcu = (F.G % 8 == 0) ? (bx % 8) * (F.G / 8) + bx / 8 : bx; }
    volatile LAS unsigned* MISC = (volatile LAS unsigned*)(F.lds + MISC_OFF);
    for (int u = F.tid; u < (LDS_BYTES - LDSCTL_OFF) / 4; u += NWAVES * 64) ((LAS unsigned*)(F.lds + LDSCTL_OFF))[u] = 0u;
    __syncthreads();
    unsigned* ctl = (unsigned*)(A.ws + WS_CTL);
    XcdBarrier bar; bar.bar = ctl + CW_BAR; bar.x = 0; bar.st = nullptr;
#if !MK_MULTI
    bar = xcd_barrier_post(ctl + CW_BAR, MISC + 8);
#define GRID_BAR() xcd_barrier(bar)
#else
#define GRID_BAR() do { } while (0)
#endif
    const int lo = args.ph_lo, hi = args.ph_hi;
#define IN(k) (lo <= (k) && (k) < hi)
#define BOTH(k) (IN(k) && IN((k) + 1))
    LAS unsigned char* ring = F.lds;

    if (IN(0)) { p0_prologue(A, F); if (BOTH(0)) GRID_BAR(); }
    if (IN(1)) {
        constexpr int GG = 24;
        if (F.vcu < GG) {
        pg8::StaticOrder S{(const char*)WSP(bf16_t, WS_CS), (const char*)WSP(bf16_t, WS_WADA), 1, NMOD / 256, GG, F.vcu, (size_t)256 * D * 2, (size_t)256 * D * 2};
        EpiMod E{WSP(float, WS_MOD), A.in[11]};
        pg8::gemm_phase<EpiMod, pg8::StaticOrder, true>(ring, D, D, D, S, E);
        } else p1_side_work(A, F, F.vcu - GG, F.G - GG);
        if (BOTH(1)) GRID_BAR();
    }
    if (IN(2)) { norm_mod_pass(A, F, A.in[0], A.in[1], A.in[8], 0, 1024, WSP(bf16_t, WS_XN), 0, M, F.vcu * NWAVES + F.wave, F.G * NWAVES); if (BOTH(2)) GRID_BAR(); }
    if (IN(3)) {
        { pg8::StaticOrder S{(const char*)WSP(bf16_t, WS_XN), (const char*)WSP(bf16_t, WS_WIN), MP / 256, NIN / 256, F.G, F.vcu, (size_t)256 * D * 2, (size_t)256 * D * 2};
        EpiIn E{WSP(bf16_t, WS_Q), WSP(bf16_t, WS_K), WSP(bf16_t, WS_V), WSP(bf16_t, WS_AP), WSP(float, WS_QS), WSP(float, WS_US), A.out, A.in[13], A.in[14]};
        pg8::gemm_phase<EpiIn, pg8::StaticOrder, true>(ring, D, D, D, S, E); }
        if (BOTH(3)) GRID_BAR();
    }
    if (IN(4)) {
        constexpr int NPW = 128, NSU = 2 * (NIN / 256);
        const bool roleA = F.vcu >= NPW; const int va = F.vcu - NPW; const bool proj = roleA && va < NSU;
        if (roleA) {
        { pg8::GroupOrder S{(const char*)WSP(bf16_t, WS_AP), (const char*)WSP(bf16_t, WS_WEND), 128, F.G - NPW, va, (size_t)256 * KA * 2, (size_t)256 * 256 * 2};
          EpiSt E{WSP(float, WS_SST)};
          pg8::gemm_phase<EpiSt, pg8::GroupOrder, true>(ring, 256, KA, 256, S, E); }
        asm volatile("s_waitcnt vmcnt(0)" ::: "memory"); __syncthreads();
        { unsigned* cw = (unsigned*)(A.ws + WS_CTL) + CW_S5C + 64 * (va >> 1);
          if (F.tid == 0) __hip_atomic_fetch_add(cw, 1u, __ATOMIC_RELAXED, __HIP_MEMORY_SCOPE_AGENT);
          if ((va & 1) == 0) {
              if (F.tid == 0) { unsigned sp = 0; unsigned* tmo = (unsigned*)(A.ws + WS_CTL) + CW_BAR + XB_TMO;
                  while (__hip_atomic_load(cw, __ATOMIC_RELAXED, __HIP_MEMORY_SCOPE_AGENT) < 2u) { __builtin_amdgcn_s_sleep(1);
                      if ((++sp & 255u) == 0u) { if (xb_ld(tmo)) break; if (sp > XB_SPIN_CAP) { atomicAdd(tmo, 1u); break; } } } }
              __syncthreads();
              __builtin_amdgcn_fence(__ATOMIC_ACQUIRE, "agent"); asm volatile("s_waitcnt vmcnt(0)" ::: "memory");
              s5_carry(A, F, (va >> 1) & 1, va >> 2);
          } }
        __syncthreads(); }
        if (proj) {
            pg8::StaticOrder S{(const char*)WSP(bf16_t, WS_XN), (const char*)WSP(bf16_t, WS_WIN), M / 256, NIN / 256, 1 << 20, (MP / 256) * (NIN / 256) + va, (size_t)256 * D * 2, (size_t)256 * D * 2};
            EpiIn E{WSP(bf16_t, WS_Q), WSP(bf16_t, WS_K), WSP(bf16_t, WS_V), WSP(bf16_t, WS_AP), WSP(float, WS_QS), WSP(float, WS_US), A.out, A.in[13], A.in[14]};
            pg8::gemm_phase<EpiIn, pg8::StaticOrder, true>(ring, D, D, D, S, E);
            signal_done(A, F, 4);
            __syncthreads();
        } else {
            prompt_attention(A, F, roleA ? 256 + va : F.vcu, 128, 2, F.vcu < 2 * NSU ? 256 + (F.vcu & (NSU - 1)) + 128 * (F.vcu >> 4) : -1);
            __syncthreads();
        }
        { if (F.tid == 0) { unsigned sp = 0; unsigned* dw = DONE_WORD(4) + 64 * (F.vcu & 7); unsigned* tmo = (unsigned*)(A.ws + WS_CTL) + CW_BAR + XB_TMO;
              while (__hip_atomic_load(dw, __ATOMIC_RELAXED, __HIP_MEMORY_SCOPE_AGENT) < 16u) { __builtin_amdgcn_s_sleep(2);
                  if ((++sp & 255u) == 0u) { if (xb_ld(tmo)) break; if (sp > XB_SPIN_CAP) { atomicAdd(tmo, 1u); break; } } } }
          __syncthreads();
          __builtin_amdgcn_fence(__ATOMIC_ACQUIRE, "agent"); asm volatile("s_waitcnt vmcnt(0)" ::: "memory"); }
        sample_attention(A, F, 1 << 30);
        sample_s5(A, F);
        if (BOTH(4)) GRID_BAR();
    }
    if (IN(6)) {
        constexpr int GG = 128;
        if (F.vcu < GG) {
        pg8::GroupOrder S{(const char*)WSP(bf16_t, WS_AP), (const char*)WSP(bf16_t, WS_TMAT), 128, GG, F.vcu, (size_t)256 * KA * 2, (size_t)256 * KA * 2};
        EpiY E{WSP(bf16_t, WS_YG)};
        pg8::gemm_phase<EpiY, pg8::GroupOrder, true>(ring, KA, KA, KA, S, E); }
        if (BOTH(6)) GRID_BAR();
    }
    if (IN(7)) {
        constexpr int GG = 132;
        if (F.vcu < GG) {
        pg8::StaticOrder S{(const char*)WSP(bf16_t, WS_YG), (const char*)WSP(bf16_t, WS_WGLU), M / 256, 2, GG, F.vcu, (size_t)256 * 512 * 2, (size_t)256 * 512 * 2};
        EpiGlu E{WSP(bf16_t, WS_YG), WSP(bf16_t, WS_MRG), WSP(float, WS_STAT)};
        pg8::gemm_phase<EpiGlu, pg8::StaticOrder, true>(ring, 512, 512, 512, S, E); }
        if (BOTH(7)) GRID_BAR();
    }
    if (IN(9)) {
        { pg8::StaticOrder S{(const char*)WSP(bf16_t, WS_MRG), (const char*)WSP(bf16_t, WS_WOUT), MP / 256, D / 256, F.G, F.vcu, (size_t)256 * D * 2, (size_t)256 * D * 2};
        EpiOut E{A.in[0], A.in[1], WSP(float, WS_MOD), WSP(float, WS_STAT), WSP(float, WS_X1)};
        pg8::gemm_phase<EpiOut, pg8::StaticOrder, true>(ring, D, D, D, S, E); }
        if (BOTH(9)) GRID_BAR();
    }
    if (IN(10)) { norm_mod_pass(A, F, WSP(float, WS_X1), WSP(float, WS_X1) + (size_t)MP * D, A.in[9], 3072, 4096, WSP(bf16_t, WS_XN), 0, MP, F.vcu * NWAVES + F.wave, F.G * NWAVES); if (BOTH(10)) GRID_BAR(); }
    if (IN(11)) {
        constexpr int GG = 242, NS = 14, NSO = 2 * (D / 256);
        if (F.vcu < GG) {
        pg8::StaticOrder S{(const char*)WSP(bf16_t, WS_XN), (const char*)WSP(bf16_t, WS_WGU), MP / 256, NGU / 256, GG, F.vcu, (size_t)256 * D * 2, (size_t)256 * D * 2};
        EpiGU E{WSP(bf16_t, WS_HB)};
        pg8::gemm_phase<EpiGU, pg8::StaticOrder, true>(ring, D, D, D, S, E); }
        else {
            const int r = F.vcu - GG;
            if (r < NSO) {
                pg8::StaticOrder S{(const char*)WSP(bf16_t, WS_MRG), (const char*)WSP(bf16_t, WS_WOUT), M / 256, D / 256, 1 << 20, (MP / 256) * (D / 256) + r, (size_t)256 * D * 2, (size_t)256 * D * 2};
                EpiOut E{A.in[0], A.in[1], WSP(float, WS_MOD), WSP(float, WS_STAT), WSP(float, WS_X1)};
                pg8::gemm_phase<EpiOut, pg8::StaticOrder, true>(ring, D, D, D, S, E);
                signal_done(A, F, 10);
            }
            wait_done(A, F, 10, NSO);
            norm_mod_pass(A, F, WSP(float, WS_X1), WSP(float, WS_X1) + (size_t)MP * D, A.in[9], 3072, 4096, WSP(bf16_t, WS_XN), MP, M, r * NWAVES + F.wave, NS * NWAVES, true);
            signal_done(A, F, 9);
            wait_done(A, F, 9, NS);
            { pg8::StaticOrder S{(const char*)WSP(bf16_t, WS_XN), (const char*)WSP(bf16_t, WS_WGU), M / 256, NGU / 256, NS, (MP / 256) * (NGU / 256) + r, (size_t)256 * D * 2, (size_t)256 * D * 2};
              EpiGU E{WSP(bf16_t, WS_HB)};
              pg8::gemm_phase<EpiGU, pg8::StaticOrder, true>(ring, D, D, D, S, E); }
        }
        if (BOTH(11)) GRID_BAR();
    }
    if (IN(12)) {
        constexpr int GG = 132;
        if (F.vcu < GG) {
        pg8::StaticOrder S{(const char*)WSP(bf16_t, WS_HB), (const char*)WSP(bf16_t, WS_WDN), M / 256, D / 256, GG, F.vcu, (size_t)256 * FF * 2, (size_t)256 * FF * 2};
        EpiDown E{WSP(float, WS_X1), WSP(float, WS_MOD), A.out};
        pg8::gemm_phase<EpiDown, pg8::StaticOrder, true>(ring, FF, FF, FF, S, E); }
        stream_copy(A, F, nullptr, 0u);
    }
#undef IN
#undef BOTH
}

extern "C" void kernel_launch(void* const* d_in, const int* in_sizes, int n_in, void* d_out, int out_size, void* d_ws, size_t ws_size, hipStream_t stream) {
    static int grid = 0;
    if (grid == 0) {
        if (n_in != 30 || ws_size < WS_END) { fprintf(stderr, "kernel_launch: unexpected n_in %d / ws %zu\n", n_in, ws_size); grid = -1; return; }
        int dev = 0, cus = 0;
        if (hipGetDevice(&dev) != hipSuccess || hipDeviceGetAttribute(&cus, hipDeviceAttributeMultiprocessorCount, dev) != hipSuccess) { grid = -1; return; }
        if (hipFuncSetAttribute((const void*)mk_fwd, hipFuncAttributeMaxDynamicSharedMemorySize, LDS_BYTES) != hipSuccess) { fprintf(stderr, "kernel_launch: hipFuncSetAttribute failed\n"); grid = -1; return; }
        int per_cu = 0;
        if (hipOccupancyMaxActiveBlocksPerMultiprocessor(&per_cu, (const void*)mk_fwd, NWAVES * 64, LDS_BYTES) != hipSuccess || per_cu < 1) fprintf(stderr, "kernel_launch: occupancy query says %d\n", per_cu);
        (void)hipGetLastError();
        grid = cus;
    }
    if (grid < 0) return;
    (void)hipMemsetAsync((char*)d_ws + WS_CTL, 0, CTL_ZERO_BYTES, stream);
    Args a{};
    for (int i = 0; i < 30; ++i) a.in[i] = (const float*)d_in[i];
    a.out = (float*)d_out; a.ws = (unsigned char*)d_ws;
#if MK_MULTI
    for (int p = 0; p < NPHASE; ++p) { a.ph_lo = p; a.ph_hi = p + 1; hipLaunchKernelGGL(mk_fwd, dim3(grid), dim3(NWAVES * 64), LDS_BYTES, stream, a); }
#else
    a.ph_lo = 0; a.ph_hi = NPHASE; hipLaunchKernelGGL(mk_fwd, dim3(grid), dim3(NWAVES * 64), LDS_BYTES, stream, a);
#endif
}
```

```cpp
#include <hip/hip_runtime.h>
#include <cstdio>
#include <cstdint>

#ifndef MK_MULTI
#define MK_MULTI 0
#endif

#define LAS __attribute__((address_space(3)))
#define GAS __attribute__((address_space(1)))
typedef unsigned short bf16_t;
typedef short bf16x8 __attribute__((ext_vector_type(8)));
typedef short s16x4 __attribute__((ext_vector_type(4)));
typedef float f32x4 __attribute__((ext_vector_type(4)));
typedef float f32x2 __attribute__((ext_vector_type(2)));
typedef unsigned u32x4 __attribute__((ext_vector_type(4)));
typedef unsigned u32x2 __attribute__((ext_vector_type(2)));

constexpr int D = 1024, SEQ = 8192, MP = 16384, MS = 512, M = MP + MS;
constexpr int KVB = 2048, NIN = 2048, FF = 2816, NMOD = 6144, NGU = 2 * FF;
constexpr int KA = 384;
constexpr int NMODROWS = 130;
constexpr float EPS = 1e-6f;
constexpr float LOG2E = 1.4426950408889634f;
constexpr float QSCALE = 0.125f * LOG2E;

constexpr size_t OFF_Y0 = 0, OFF_Y1 = 16777216, OFF_KP = 17301504, OFF_VP = 19398656, OFF_HRP = 21495808, OFF_HIP = 21499904,
                 OFF_KS = 21504000, OFF_VS = 155721728, OFF_HRS = 289939456, OFF_HIS = 290201600;

constexpr size_t MiB = 1u << 20;
constexpr size_t WS_CTL = 0, CTL_ZERO_BYTES = 1 * MiB;
constexpr size_t WS_WADA = 1 * MiB;
constexpr size_t WS_WIN = 13 * MiB;
constexpr size_t WS_WGLU = 17 * MiB;
constexpr size_t WS_WOUT = 18 * MiB;
constexpr size_t WS_WGU = 20 * MiB;
constexpr size_t WS_WDN = 31 * MiB;
constexpr size_t WS_TMAT = 37 * MiB;
constexpr size_t WS_WEND = 43 * MiB;
constexpr size_t WS_CS = 47 * MiB;
constexpr size_t WS_MOD = 48 * MiB;
constexpr size_t WS_XN = 52 * MiB;
constexpr size_t WS_Q = 86 * MiB;
constexpr size_t WS_K = 102 * MiB;
constexpr size_t WS_V = 118 * MiB;
constexpr size_t WS_QS = 134 * MiB;
constexpr size_t WS_US = 135 * MiB;
constexpr size_t WS_AP = 136 * MiB;
constexpr size_t WS_SST = 160 * MiB;
constexpr size_t WS_YG = 176 * MiB;
constexpr size_t WS_MRG = 193 * MiB;
constexpr size_t WS_X1 = 227 * MiB;
constexpr size_t WS_HB = 294 * MiB;
constexpr size_t WS_STAT = 385 * MiB;
constexpr size_t WS_END = 386 * MiB;
constexpr int CW_TMO = 0, CW_BAR = 4096;
constexpr int CW_S5C = 20480;
constexpr int CW_CPCTR = 8192, CW_QP = 8256, CW_QS = 8320, CW_DONE = 8448;

constexpr int RING_BYTES = 131072, LDSCTL_OFF = RING_BYTES, MISC_OFF = LDSCTL_OFF + 320, LDS_BYTES = 147456;
constexpr int NWAVES = 8;

__device__ __forceinline__ unsigned cvt_pk_bf16(float lo, float hi) { unsigned r; asm volatile("v_cvt_pk_bf16_f32 %0, %1, %2" : "=v"(r) : "v"(lo), "v"(hi)); return r; }
__device__ __forceinline__ float bf2f(unsigned short b) { return __uint_as_float((unsigned)b << 16); }
__device__ __forceinline__ float bflo(unsigned w) { return __uint_as_float(w << 16); }
__device__ __forceinline__ float bfhi(unsigned w) { return __uint_as_float(w & 0xffff0000u); }
template <int CTRL> __device__ __forceinline__ float dpp_mov(float v) { return __int_as_float(__builtin_amdgcn_update_dpp(0, __float_as_int(v), CTRL, 0xf, 0xf, true)); }
__device__ __forceinline__ float row16_sum(float v) {
    v += dpp_mov<0xB1>(v);
    v += dpp_mov<0x4E>(v);
    v += dpp_mov<0x141>(v);
    v += dpp_mov<0x140>(v);
    return v;
}
__device__ __forceinline__ float rdlane(float v, int l) { return __int_as_float(__builtin_amdgcn_readlane(__float_as_int(v), l)); }
__device__ __forceinline__ float wave_sum(float v) {
    v = row16_sum(v);
    return (rdlane(v, 0) + rdlane(v, 16)) + (rdlane(v, 32) + rdlane(v, 48));
}
__device__ __forceinline__ float fexp2(float x) { return __builtin_amdgcn_exp2f(x); }
__device__ __forceinline__ float frcp(float x) { return __builtin_amdgcn_rcpf(x); }
__device__ __forceinline__ float sigmoidf_(float x) { return frcp(1.0f + fexp2(-x * LOG2E)); }
__device__ __forceinline__ float siluf_(float x) { return x * sigmoidf_(x); }
__device__ __forceinline__ float gelu_tanh(float x) { const float z = 0.7978845608028654f * (x + 0.044715f * x * x * x); return x * frcp(1.0f + fexp2(-2.0f * LOG2E * z)); }
__device__ __forceinline__ u32x4 pack8(f32x4 a, f32x4 b) { u32x4 w; w.x = cvt_pk_bf16(a[0], a[1]); w.y = cvt_pk_bf16(a[2], a[3]); w.z = cvt_pk_bf16(b[0], b[1]); w.w = cvt_pk_bf16(b[2], b[3]); return w; }

__device__ __forceinline__ void wt16f(const void* base, unsigned off, f32x4 v) { __builtin_amdgcn_raw_buffer_store_b128(__builtin_bit_cast(u32x4, v), __builtin_amdgcn_make_buffer_rsrc((void*)base, 0, 0xffffffffu, 0x00020000), (int)off, 0, 16); }

__device__ __forceinline__ double dexp_small(double x) {
    const double y = x * 0.125;
    double t = 1.0 + y * (1.0 / 12.0);
    t = 1.0 + t * y * (1.0 / 11.0); t = 1.0 + t * y * (1.0 / 10.0); t = 1.0 + t * y * (1.0 / 9.0); t = 1.0 + t * y * (1.0 / 8.0); t = 1.0 + t * y * (1.0 / 7.0); t = 1.0 + t * y * (1.0 / 6.0);
    t = 1.0 + t * y * (1.0 / 5.0); t = 1.0 + t * y * (1.0 / 4.0); t = 1.0 + t * y * (1.0 / 3.0); t = 1.0 + t * y * (1.0 / 2.0); t = 1.0 + t * y;
    t = t * t; t = t * t; t = t * t; return t;
}
__device__ __forceinline__ void dsincos(double a, double& s, double& c) {
    const double k = __builtin_rint(a * 0.63661977236758134308);
    const double y = (a - k * 1.57079632679489655800) - k * 6.123233995736766036e-17;
    const double y2 = y * y;
    const double sp = y * (1.0 + y2 * (-1.0 / 6 + y2 * (1.0 / 120 + y2 * (-1.0 / 5040 + y2 * (1.0 / 362880 + y2 * (-1.0 / 39916800 + y2 * (1.0 / 6227020800.0)))))));
    const double cp = 1.0 + y2 * (-0.5 + y2 * (1.0 / 24 + y2 * (-1.0 / 720 + y2 * (1.0 / 40320 + y2 * (-1.0 / 3628800 + y2 * (1.0 / 479001600.0 + y2 * (-1.0 / 87178291200.0)))))));
    const long long q = (long long)k & 3;
    s = (q == 0) ? sp : (q == 1) ? cp : (q == 2) ? -sp : -cp;
    c = (q == 0) ? cp : (q == 1) ? -sp : (q == 2) ? -cp : sp;
}
__device__ __forceinline__ void abar_pow(double j, double dt, double lr, double li, double& re, double& im) {
    const double mag = dexp_small(j * dt * lr); double s, c; dsincos(j * dt * li, s, c); re = mag * c; im = mag * s;
}

namespace pg8 {
constexpr int BM = 256, BK = 64, HALF = 128, HTB = HALF * BK * 2, STAGE_BYTES = 8 * HTB;
__host__ __device__ __forceinline__ int lds_byte(int r, int c) { const int st = (r >> 4) * 2 + (c >> 5), rr = r & 15, cc = c & 31, ob = rr * 64 + cc * 2; return st * 1024 + (ob ^ (((ob >> 9) & 1) << 5)); }
__host__ __device__ __forceinline__ void stage_rc(int b, int& R, int& C) { const int st = b / 1024, sb = b % 1024, swz = sb ^ (((sb >> 9) & 1) << 5); R = (st >> 1) * 16 + swz / 64; C = (st & 1) * 32 + (swz % 64) / 2; }
__host__ __device__ __forceinline__ int perm32(int rho) { const int n = rho >> 4, i = rho & 15; return 8 * (i >> 2) + 4 * n + (i & 3); }

struct Unit { int pm, pn; const char* a; const char* b; };

struct StaticOrder {
    const char* A; const char* B; int nM, nN, G, c; size_t strideA, strideB;
    __device__ __forceinline__ bool next(int i, Unit& u) const {
        const int L = i * G + c; if (L >= nM * nN) return false;
        u.pm = L / nN; u.pn = L - u.pm * nN; u.a = A + (size_t)u.pm * strideA; u.b = B + (size_t)u.pn * strideB; return true;
    }
};
struct GroupOrder {
    const char* A; const char* B; int nM, G, c; size_t strideA, strideB;
    __device__ __forceinline__ bool next(int i, Unit& u) const {
        const int L = i * G + c; if (L >= nM) return false;
        u.pm = L; u.pn = 0; u.a = A + (size_t)L * strideA; u.b = B + (size_t)(L >> 2) * strideB; return true;
    }
};

template <class Epi, class Sched, bool ALIGN_EPI>
__device__ __forceinline__ void gemm_phase(LAS unsigned char* lds, const int K, const int lda, const int ldb, const Sched& S, const Epi& E) {
    const int tid = threadIdx.x, wid = __builtin_amdgcn_readfirstlane(tid >> 6), lane = tid & 63, wr = wid >> 2, wc = wid & 3, fr = lane & 15, fq = lane >> 4;
    const int nt = K / BK;
    unsigned voffA[2], voffB[2];
#pragma unroll
    for (int i = 0; i < 2; ++i) { int R, C; stage_rc(tid * 16 + i * 8192, R, C); const int Rb = (R & ~31) + perm32(R & 31);
        voffA[i] = (unsigned)(R * lda + C) * 2u; voffB[i] = (unsigned)(Rb * ldb + C) * 2u; }
    const size_t kstep = (size_t)(BK * 2);
    const size_t hstepA = (size_t)HALF * lda * 2, hstepB = (size_t)HALF * ldb * 2;
    const unsigned ldsw = (unsigned)wid * 1024u;
    const int aoff = lds_byte(wr * 64 + fr, fq * 8), boff = lds_byte(wc * 32 + fr, fq * 8);
#define PG8_SA(b, h) (((b) * 2 + (h)) * HTB)
#define PG8_SB(b, h) ((4 + (b) * 2 + (h)) * HTB)
#define PG8_STAGE(bufoff, gbase, voff) do { _Pragma("unroll") for (int _i = 0; _i < 2; ++_i) { unsigned _vo = (voff)[_i]; asm volatile("" : "+v"(_vo)); \
        __builtin_amdgcn_global_load_lds((const unsigned*)((const char*)(gbase) + _vo), (LAS unsigned*)(lds + (bufoff) + ldsw + _i * 8192), 16, 0, 0); } } while (0)
#define PG8_LDA(dst, b, h) do { _Pragma("unroll") for (int m = 0; m < 4; ++m) _Pragma("unroll") for (int k = 0; k < 2; ++k) dst[m][k] = *(const LAS bf16x8*)(lds + PG8_SA(b, h) + aoff + m * 2048 + k * 1024); } while (0)
#define PG8_LDB(dst, b, h) do { _Pragma("unroll") for (int n = 0; n < 2; ++n) _Pragma("unroll") for (int k = 0; k < 2; ++k) dst[n][k] = *(const LAS bf16x8*)(lds + PG8_SB(b, h) + boff + n * 2048 + k * 1024); } while (0)
#define PG8_MMA(ai, bj, At, Bt) do { __builtin_amdgcn_s_setprio(1); _Pragma("unroll") for (int m = 0; m < 4; ++m) _Pragma("unroll") for (int n = 0; n < 2; ++n) _Pragma("unroll") for (int k = 0; k < 2; ++k) \
        acc[ai][bj][m][n] = __builtin_amdgcn_mfma_f32_16x16x32_bf16(Bt[n][k], At[m][k], acc[ai][bj][m][n], 0, 0, 0); __builtin_amdgcn_s_setprio(0); } while (0)
#define PG8_WAIT_V(n) asm volatile("s_waitcnt vmcnt(" #n ")" ::: "memory")
#define PG8_WAIT_L(n) asm volatile("s_waitcnt lgkmcnt(" #n ")" ::: "memory")
#define PG8_BAR __builtin_amdgcn_s_barrier()
#define PG8_SCHED __builtin_amdgcn_sched_barrier(0)
    Unit cur, nxt; int ui = 0;
    if (!S.next(0, cur)) return;
    f32x4 acc[2][2][4][2];
#pragma unroll
    for (int a = 0; a < 2; ++a)
#pragma unroll
        for (int b = 0; b < 2; ++b)
#pragma unroll
            for (int m = 0; m < 4; ++m)
#pragma unroll
                for (int n = 0; n < 2; ++n) acc[a][b][m][n] = (f32x4){0.f, 0.f, 0.f, 0.f};
    bf16x8 At[4][2], B0[2][2], B1[2][2];
    const char* cA = cur.a; const char* cB = cur.b;
    PG8_STAGE(PG8_SB(0, 0), cB, voffB); PG8_STAGE(PG8_SB(0, 1), cB + hstepB, voffB); PG8_STAGE(PG8_SA(0, 0), cA, voffA); PG8_STAGE(PG8_SA(0, 1), cA + hstepA, voffA);
    if (wr == 1) PG8_BAR;
    PG8_WAIT_V(2); PG8_BAR;
    PG8_STAGE(PG8_SB(1, 0), cB + kstep, voffB); PG8_STAGE(PG8_SA(1, 0), cA + kstep, voffA); PG8_STAGE(PG8_SB(1, 1), cB + hstepB + kstep, voffB);
    PG8_WAIT_V(6); PG8_BAR;
    for (;;) {
        const bool has_next = S.next(ui + 1, nxt);
        const char* nA = has_next ? nxt.a : cA; const char* nB = has_next ? nxt.b : cB;
        for (int t = 0; t < nt; t += 2) {
            if constexpr (Epi::MIDK) { if (t == (nt >> 1)) E.mid(acc, cur, wr, fr); }
            const bool last = (t == nt - 2);
            const char* a1 = cA + (size_t)(t + 1) * kstep;
            const char* a2 = last ? nA : cA + (size_t)(t + 2) * kstep; const char* b2 = last ? nB : cB + (size_t)(t + 2) * kstep;
            const char* a3 = a2 + kstep; const char* b3 = b2 + kstep;
            PG8_LDB(B0, 0, 0); PG8_LDB(B1, 0, 1); PG8_SCHED; PG8_LDA(At, 0, 0); PG8_STAGE(PG8_SA(1, 1), a1 + hstepA, voffA);
            PG8_WAIT_V(8); PG8_WAIT_L(0); PG8_BAR; PG8_MMA(0, 0, At, B0); PG8_MMA(0, 1, At, B1); PG8_BAR; PG8_SCHED;
            PG8_LDA(At, 0, 1); PG8_STAGE(PG8_SB(0, 0), b2, voffB); PG8_STAGE(PG8_SB(0, 1), b2 + hstepB, voffB); PG8_STAGE(PG8_SA(0, 0), a2, voffA);
            PG8_WAIT_V(8); PG8_WAIT_L(0); PG8_BAR; PG8_MMA(1, 0, At, B0); PG8_MMA(1, 1, At, B1); PG8_BAR; PG8_SCHED;
            PG8_LDB(B0, 1, 0); PG8_LDB(B1, 1, 1); PG8_SCHED; PG8_LDA(At, 1, 0); PG8_STAGE(PG8_SA(0, 1), a2 + hstepA, voffA);
            PG8_WAIT_V(8); PG8_WAIT_L(0); PG8_BAR; PG8_MMA(0, 0, At, B0); PG8_MMA(0, 1, At, B1); PG8_BAR; PG8_SCHED;
            PG8_LDA(At, 1, 1); PG8_STAGE(PG8_SB(1, 0), b3, voffB); PG8_STAGE(PG8_SB(1, 1), b3 + hstepB, voffB); PG8_STAGE(PG8_SA(1, 0), a3, voffA);
            PG8_WAIT_V(8); PG8_WAIT_L(0); PG8_BAR; PG8_MMA(1, 0, At, B0); PG8_MMA(1, 1, At, B1); PG8_BAR; PG8_SCHED;
        }
        if constexpr (ALIGN_EPI) { if (wr == 0) PG8_BAR; }
        E(acc, cur, wr, wc, fr, fq);
        if (!has_next) break;
#pragma unroll
        for (int a = 0; a < 2; ++a)
#pragma unroll
            for (int b = 0; b < 2; ++b)
#pragma unroll
                for (int m = 0; m < 4; ++m)
#pragma unroll
                    for (int n = 0; n < 2; ++n) acc[a][b][m][n] = (f32x4){0.f, 0.f, 0.f, 0.f};
        cur = nxt; cA = nA; cB = nB; ++ui;
        if constexpr (ALIGN_EPI) { if (wr == 1) PG8_BAR; }
    }
    PG8_WAIT_V(0);
    if constexpr (!ALIGN_EPI) { if (wr == 0) PG8_BAR; }
    PG8_BAR;
#undef PG8_SA
#undef PG8_SB
#undef PG8_STAGE
#undef PG8_LDA
#undef PG8_LDB
#undef PG8_MMA
#undef PG8_WAIT_V
#undef PG8_WAIT_L
#undef PG8_BAR
#undef PG8_SCHED
}
}
using pg8::Unit;
typedef f32x4 Acc[2][2][4][2];

__device__ __forceinline__ int mod_row(int row) { return row < MP ? (row >> 13) : 2 + ((row - MP) >> 2); }

struct EpiMod {
    static constexpr bool MIDK = false;
    float* MOD; const float* bada;
    __device__ __forceinline__ void operator()(const Acc& acc, const Unit& u, int wr, int wc, int fr, int fq) const {
        asm volatile("" : "+v"(fr), "+v"(fq));
#pragma unroll
        for (int ai = 0; ai < 2; ++ai)
#pragma unroll
            for (int m = 0; m < 4; ++m) { const int row = u.pm * 256 + ai * 128 + wr * 64 + m * 16 + fr;
                if (row < NMODROWS) {
#pragma unroll
                    for (int bj = 0; bj < 2; ++bj) { const int col = u.pn * 256 + bj * 128 + wc * 32 + 8 * fq;
                        const f32x4 b0 = *(const f32x4*)(bada + col), b1 = *(const f32x4*)(bada + col + 4);
                        *(f32x4*)(MOD + (size_t)row * NMOD + col) = acc[ai][bj][m][0] + b0; *(f32x4*)(MOD + (size_t)row * NMOD + col + 4) = acc[ai][bj][m][1] + b1; } } }
    }
};
struct EpiIn {
    static constexpr bool MIDK = false;
    bf16_t *Qb, *Kb, *Vb, *AP; float *QS, *US, *out; const float *qg, *kg;
    __device__ __forceinline__ void operator()(const Acc& acc, const Unit& u, int wr, int wc, int fr, int fq) const {
        asm volatile("" : "+v"(fr), "+v"(fq));
        const int kind = u.pn >> 1, half = u.pn & 1, head = 4 * half + wc;
        const bool prompt = u.pm < 64;
        f32x4 g00 = {1.f, 1.f, 1.f, 1.f}, g01 = g00, g10 = g00, g11 = g00;
        if (kind <= 1) { const float* gp = kind == 0 ? qg : kg; g00 = *(const f32x4*)(gp + 8 * fq); g01 = *(const f32x4*)(gp + 8 * fq + 4); g10 = *(const f32x4*)(gp + 32 + 8 * fq); g11 = *(const f32x4*)(gp + 32 + 8 * fq + 4); }
#pragma unroll
        for (int ai = 0; ai < 2; ++ai)
#pragma unroll
            for (int m = 0; m < 4; ++m) {
                const int row = u.pm * 256 + ai * 128 + wr * 64 + m * 16 + fr;
                f32x4 a0 = acc[ai][0][m][0], a1 = acc[ai][0][m][1], b0 = acc[ai][1][m][0], b1 = acc[ai][1][m][1];
                if (kind <= 1) {
                    float ss = 0.f;
#pragma unroll
                    for (int e = 0; e < 4; ++e) ss += a0[e] * a0[e] + a1[e] * a1[e] + b0[e] * b0[e] + b1[e] * b1[e];
                    ss += __shfl_xor(ss, 16); ss += __shfl_xor(ss, 32);
                    float rs = __builtin_amdgcn_rsqf(ss * (1.0f / 64.0f) + EPS);
                    if (kind == 0) rs *= QSCALE;
                    a0 = a0 * g00 * rs; a1 = a1 * g01 * rs; b0 = b0 * g10 * rs; b1 = b1 * g11 * rs;
                }
                const int c0 = head * 64 + 8 * fq;
                if (kind == 0) {
                    if (prompt) { *(u32x4*)(Qb + (size_t)row * 512 + c0) = pack8(a0, a1); *(u32x4*)(Qb + (size_t)row * 512 + c0 + 32) = pack8(b0, b1); }
                    else { const unsigned o_ = ((unsigned)(row - MP) * 512u + c0) * 4u; wt16f(QS, o_, a0); wt16f(QS, o_ + 16u, a1); wt16f(QS, o_ + 128u, b0); wt16f(QS, o_ + 144u, b1); }
                } else if (kind <= 2) {
                    bf16_t* Bb = kind == 1 ? Kb : Vb; float* o = out + (kind == 1 ? OFF_KP : OFF_VP); float* os = out + (kind == 1 ? OFF_KS : OFF_VS);
                    if (prompt) {
                        *(u32x4*)(Bb + (size_t)row * 512 + c0) = pack8(a0, a1); *(u32x4*)(Bb + (size_t)row * 512 + c0 + 32) = pack8(b0, b1);
                        const int b = row >> 13, t = row & 8191;
                        if (t >= SEQ - KVB) { float* p = o + ((size_t)b * KVB + (t - (SEQ - KVB))) * 512 + c0; *(f32x4*)p = a0; *(f32x4*)(p + 4) = a1; *(f32x4*)(p + 32) = b0; *(f32x4*)(p + 36) = b1; }
                    } else {
                        const int rs_ = row - MP, bs = rs_ >> 2, t = rs_ & 3;
                        const unsigned o_ = (((unsigned)bs * KVB + (KVB - 4) + t) * 512u + c0) * 4u; wt16f(os, o_, a0); wt16f(os, o_ + 16u, a1); wt16f(os, o_ + 128u, b0); wt16f(os, o_ + 144u, b1);
                    }
                } else {
                    if (prompt) {
                        const int g0 = 16 * half + 4 * wc + (fq >> 1), cc = 8 * (fq & 1);
                        bf16_t* p0 = AP + ((size_t)g0 * 1024 + (row >> 4)) * KA + (row & 15) * 16 + cc;
                        *(u32x4*)p0 = pack8(a0, a1); *(u32x4*)(p0 + (size_t)2 * 1024 * KA) = pack8(b0, b1);
                    } else { const unsigned o_ = ((unsigned)(row - MP) * 512u + c0) * 4u; wt16f(US, o_, a0); wt16f(US, o_ + 16u, a1); wt16f(US, o_ + 128u, b0); wt16f(US, o_ + 144u, b1); }
                }
            }
    }
};
struct EpiSt {
    static constexpr bool MIDK = false;
    float* SST;
    __device__ __forceinline__ void operator()(const Acc& acc, const Unit& u, int wr, int wc, int fr, int fq) const {
        asm volatile("" : "+v"(fr), "+v"(fq));
#pragma unroll
        for (int ai = 0; ai < 2; ++ai)
#pragma unroll
            for (int m = 0; m < 4; ++m) { const int row = u.pm * 256 + ai * 128 + wr * 64 + m * 16 + fr; const unsigned o_ = ((unsigned)row * 128u + wc * 32 + 8 * fq) * 4u;
                wt16f(SST, o_, acc[ai][0][m][0]); wt16f(SST, o_ + 16u, acc[ai][0][m][1]); }
    }
};
struct EpiY {
    static constexpr bool MIDK = false;
    bf16_t* YG;
    __device__ __forceinline__ void operator()(const Acc& acc, const Unit& u, int wr, int wc, int fr, int fq) const {
        asm volatile("" : "+v"(fr), "+v"(fq));
        const int g = u.pm >> 2;
#pragma unroll
        for (int ai = 0; ai < 2; ++ai)
#pragma unroll
            for (int m = 0; m < 4; ++m) { const int R = u.pm * 256 + ai * 128 + wr * 64 + m * 16 + fr, chunk = R & 1023;
#pragma unroll
                for (int bj = 0; bj < 2; ++bj) { const int tt = 8 * bj + 2 * wc + (fq >> 1), cc = 8 * (fq & 1);
                    f32x4 v0 = acc[ai][bj][m][0], v1 = acc[ai][bj][m][1];
#pragma unroll
                    for (int e = 0; e < 4; ++e) { v0[e] = gelu_tanh(v0[e]); v1[e] = gelu_tanh(v1[e]); }
                    *(u32x4*)(YG + (size_t)(chunk * 16 + tt) * 512 + g * 16 + cc) = pack8(v0, v1); } }
    }
};
struct EpiGlu {
    static constexpr bool MIDK = false;
    const bf16_t* YG; bf16_t* MRG; float* STAT;
    __device__ __forceinline__ void operator()(const Acc& acc, const Unit& u, int wr, int wc, int fr, int fq) const {
        asm volatile("" : "+v"(fr), "+v"(fq));
#pragma unroll
        for (int ai = 0; ai < 2; ++ai)
#pragma unroll
            for (int m = 0; m < 4; ++m) { const int row = u.pm * 256 + ai * 128 + wr * 64 + m * 16 + fr; float ss = 0.f;
#pragma unroll
                for (int bj = 0; bj < 2; ++bj) { const int col = u.pn * 256 + bj * 128 + wc * 32 + 8 * fq;
                    const u32x4 yw = *(const u32x4*)(YG + (size_t)row * 512 + col);
                    f32x4 v0 = acc[ai][bj][m][0], v1 = acc[ai][bj][m][1];
                    v0[0] = bflo(yw.x) * sigmoidf_(v0[0]); v0[1] = bfhi(yw.x) * sigmoidf_(v0[1]); v0[2] = bflo(yw.y) * sigmoidf_(v0[2]); v0[3] = bfhi(yw.y) * sigmoidf_(v0[3]);
                    v1[0] = bflo(yw.z) * sigmoidf_(v1[0]); v1[1] = bfhi(yw.z) * sigmoidf_(v1[1]); v1[2] = bflo(yw.w) * sigmoidf_(v1[2]); v1[3] = bfhi(yw.w) * sigmoidf_(v1[3]);
#pragma unroll
                    for (int e = 0; e < 4; ++e) ss += v0[e] * v0[e] + v1[e] * v1[e];
                    *(u32x4*)(MRG + (size_t)row * 1024 + 512 + col) = pack8(v0, v1); }
                ss += __shfl_xor(ss, 16); ss += __shfl_xor(ss, 32);
                if (fq == 0) atomicAdd(STAT + (size_t)row * 2 + 1, ss); }
    }
};
struct EpiOut {
    static constexpr bool MIDK = true;
    const float *xp, *xs, *MOD, *STAT; float* X1;
    __device__ __forceinline__ void mid(Acc& acc, const Unit& u, int wr, int fr) const {
        asm volatile("" : "+v"(fr));
#pragma unroll
        for (int ai = 0; ai < 2; ++ai)
#pragma unroll
            for (int m = 0; m < 4; ++m) { const int row = u.pm * 256 + ai * 128 + wr * 64 + m * 16 + fr;
                const f32x2 st = *(const f32x2*)(STAT + (size_t)row * 2);
                const float ratio = __builtin_amdgcn_rsqf(st[0] * (1.0f / 512.0f) + EPS) * __builtin_sqrtf(st[1] * (1.0f / 512.0f) + EPS);
#pragma unroll
                for (int bj = 0; bj < 2; ++bj) { acc[ai][bj][m][0] = acc[ai][bj][m][0] * ratio; acc[ai][bj][m][1] = acc[ai][bj][m][1] * ratio; } }
    }
    __device__ __forceinline__ void operator()(const Acc& acc, const Unit& u, int wr, int wc, int fr, int fq) const {
        asm volatile("" : "+v"(fr), "+v"(fq));
#pragma unroll
        for (int ai = 0; ai < 2; ++ai)
#pragma unroll
            for (int m = 0; m < 4; ++m) { const int row = u.pm * 256 + ai * 128 + wr * 64 + m * 16 + fr;
                const float* xr = row < MP ? xp + (size_t)row * D : xs + (size_t)(row - MP) * D; const float* gr = MOD + (size_t)mod_row(row) * NMOD + 2048;
                const float rb = __builtin_amdgcn_rsqf(STAT[(size_t)row * 2 + 1] * (1.0f / 512.0f) + EPS);
#pragma unroll
                for (int bj = 0; bj < 2; ++bj) { const int col = u.pn * 256 + bj * 128 + wc * 32 + 8 * fq;
                    const f32x4 x0 = *(const f32x4*)(xr + col), x1 = *(const f32x4*)(xr + col + 4), g0 = *(const f32x4*)(gr + col) * rb, g1 = *(const f32x4*)(gr + col + 4) * rb;
                    if (u.pm >= MP / 256) { const unsigned o_ = ((unsigned)row * D + col) * 4u; wt16f(X1, o_, x0 + g0 * acc[ai][bj][m][0]); wt16f(X1, o_ + 16u, x1 + g1 * acc[ai][bj][m][1]); }
                    else { *(f32x4*)(X1 + (size_t)row * D + col) = x0 + g0 * acc[ai][bj][m][0]; *(f32x4*)(X1 + (size_t)row * D + col + 4) = x1 + g1 * acc[ai][bj][m][1]; } } }
    }
};
struct EpiGU {
    static constexpr bool MIDK = false;
    bf16_t* HB;
    __device__ __forceinline__ void operator()(const Acc& acc, const Unit& u, int wr, int wc, int fr, int fq) const {
        asm volatile("" : "+v"(fr), "+v"(fq));
#pragma unroll
        for (int ai = 0; ai < 2; ++ai)
#pragma unroll
            for (int m = 0; m < 4; ++m) { const int row = u.pm * 256 + ai * 128 + wr * 64 + m * 16 + fr;
                f32x4 v0, v1;
#pragma unroll
                for (int e = 0; e < 4; ++e) { v0[e] = siluf_(acc[ai][0][m][0][e]) * acc[ai][1][m][0][e]; v1[e] = siluf_(acc[ai][0][m][1][e]) * acc[ai][1][m][1][e]; }
                *(u32x4*)(HB + (size_t)row * FF + u.pn * 128 + wc * 32 + 8 * fq) = pack8(v0, v1); }
    }
};
struct EpiDown {
    static constexpr bool MIDK = false;
    const float *X1, *MOD; float* out;
    __device__ __forceinline__ void operator()(const Acc& acc, const Unit& u, int wr, int wc, int fr, int fq) const {
        asm volatile("" : "+v"(fr), "+v"(fq));
#pragma unroll
        for (int ai = 0; ai < 2; ++ai)
#pragma unroll
            for (int m = 0; m < 4; ++m) { const int row = u.pm * 256 + ai * 128 + wr * 64 + m * 16 + fr;
                const float* xr = X1 + (size_t)row * D; const float* gr = MOD + (size_t)mod_row(row) * NMOD + 5120;
                float* orow = row < MP ? out + OFF_Y0 + (size_t)row * D : out + OFF_Y1 + (size_t)(row - MP) * D;
#pragma unroll
                for (int bj = 0; bj < 2; ++bj) { const int col = u.pn * 256 + bj * 128 + wc * 32 + 8 * fq;
                    const f32x4 x0 = *(const f32x4*)(xr + col), x1 = *(const f32x4*)(xr + col + 4), g0 = *(const f32x4*)(gr + col), g1 = *(const f32x4*)(gr + col + 4);
                    *(f32x4*)(orow + col) = x0 + g0 * acc[ai][bj][m][0]; *(f32x4*)(orow + col + 4) = x1 + g1 * acc[ai][bj][m][1]; } }
    }
};

#define XB_TMO      128
#define XB_XCNT(j)  (256  + 64 * (j))
#define XB_XSUB(j)  (1280 + 64 * (j))
#define XB_XGEN(j)  (2304 + 64 * (j))
#define XB_TOP      3328
#define XB_TOPGEN   3392
#define XCD_BAR_WORDS 3456
#define XB_SPIN_CAP (1u << 18)
__device__ __forceinline__ unsigned xb_ld(unsigned* p)              { return __hip_atomic_load(p, __ATOMIC_RELAXED, __HIP_MEMORY_SCOPE_AGENT); }
__device__ __forceinline__ unsigned xb_add(unsigned* p, unsigned v) { return __hip_atomic_fetch_add(p, v, __ATOMIC_RELAXED, __HIP_MEMORY_SCOPE_AGENT); }
__device__ __forceinline__ unsigned xb_xcc_id() { return (unsigned)__builtin_amdgcn_s_getreg((3 << 11) | 20) & 0xFu; }
#define XB_SPIN(cond, bar) do { unsigned _sp = 0; while (cond) { __builtin_amdgcn_s_sleep(1); \
    if ((++_sp & 255u) == 0u) { if (xb_ld(&(bar)[XB_TMO])) break; if (_sp > XB_SPIN_CAP) { atomicAdd(&(bar)[XB_TMO], 1u); break; } } } } while (0)
struct XcdBarrier { unsigned* bar; unsigned x; volatile LAS unsigned* st; };
__device__ __forceinline__ XcdBarrier xcd_barrier_post(unsigned* bar, volatile LAS unsigned* st) {
    XcdBarrier b; b.bar = bar; b.x = xb_xcc_id(); b.st = st;
    if (threadIdx.x == 0) (void)xb_add(&bar[XB_XCNT(b.x)], 1u);
    return b;
}
__device__ __forceinline__ void xcd_barrier_complete(unsigned* bar, unsigned x, unsigned& nloc, unsigned& nx) {
    const unsigned G = gridDim.x * gridDim.y * gridDim.z;
    unsigned sum, cnt, mine, sp = 0u;
    for (;;) {
        sum = 0u; cnt = 0u; mine = 0u;
#pragma unroll
        for (unsigned j = 0; j < 16; ++j) { const unsigned c = xb_ld(&bar[XB_XCNT(j)]); sum += c; cnt += (c > 0u) ? 1u : 0u; mine = (j == x) ? c : mine; }
        if (sum == G) break;
        __builtin_amdgcn_s_sleep(1);
        if ((++sp & 255u) == 0u) { if (xb_ld(&bar[XB_TMO])) break; if (sp > XB_SPIN_CAP) { atomicAdd(&bar[XB_TMO], 1u); break; } }
    }
    nloc = mine > 0u ? mine : 1u; nx = cnt > 0u ? cnt : 1u;
}
__device__ __forceinline__ void xcd_barrier(const XcdBarrier& b) {
    asm volatile("s_waitcnt vmcnt(0)" ::: "memory");
    __syncthreads();
    if (threadIdx.x == 0) {
        unsigned* bar = b.bar;
        __builtin_amdgcn_s_waitcnt(0);
        unsigned nloc = b.st[0], nx = b.st[1];
        if (nloc == 0u) { xcd_barrier_complete(bar, b.x, nloc, nx); b.st[0] = nloc; b.st[1] = nx; }
        const unsigned old = xb_add(&bar[XB_XSUB(b.x)], 1u);
        const unsigned gen = old / nloc;
        if (old + 1u == (gen + 1u) * nloc) {
            __builtin_amdgcn_fence(__ATOMIC_RELEASE, "agent");
            asm volatile("s_waitcnt vmcnt(0)" ::: "memory");
            const unsigned og = xb_add(&bar[XB_TOP], 1u);
            const unsigned tg = og / nx;
            if (og + 1u == (tg + 1u) * nx) xb_add(&bar[XB_TOPGEN], 1u);
            else XB_SPIN(xb_ld(&bar[XB_TOPGEN]) == tg, bar);
            __builtin_amdgcn_fence(__ATOMIC_ACQUIRE, "agent");
            xb_add(&bar[XB_XGEN(b.x)], 1u);
            asm volatile("s_waitcnt vmcnt(0)" ::: "memory");
        } else {
            XB_SPIN(xb_ld(&bar[XB_XGEN(b.x)]) == gen, bar);
            __builtin_amdgcn_fence(__ATOMIC_ACQUIRE, "agent");
            asm volatile("s_waitcnt vmcnt(0)" ::: "memory");
        }
    }
    __syncthreads();
}

struct Args { const float* in[30]; float* out; unsigned char* ws; int ph_lo, ph_hi; };
struct Frame {
    LAS unsigned char* lds; int tid, lane, wave, vcu, G;
};
#define WSP(T, off) ((T*)(A.ws + (off)))

template <class RowMap>
__device__ __forceinline__ void p0_transpose_item(const float* W, int K, int N, bf16_t* WT, const RowMap& rm, LAS float* scr, int item, int lane, const float* kgain = nullptr) {
    const int nblk = N / 32, kb = item / nblk, nb = item % nblk, k0 = 64 * kb, n0 = 32 * nb;
    { const int kq = lane >> 3, nq = lane & 7; f32x4 v[8];
#pragma unroll
      for (int i = 0; i < 8; ++i) v[i] = *(const f32x4*)(W + (size_t)(k0 + 8 * i + kq) * N + n0 + 4 * nq);
#pragma unroll
      for (int i = 0; i < 8; ++i) { LAS float* d = scr + (8 * i + kq) * 33 + 4 * nq; d[0] = v[i][0]; d[1] = v[i][1]; d[2] = v[i][2]; d[3] = v[i][3]; } }
    asm volatile("s_waitcnt lgkmcnt(0)" ::: "memory");
    const int c = lane & 7;
    f32x4 ga = {1.f, 1.f, 1.f, 1.f}, gb = ga;
    if (kgain) { ga = *(const f32x4*)(kgain + k0 + 8 * c); gb = *(const f32x4*)(kgain + k0 + 8 * c + 4); }
#pragma unroll
    for (int j = 0; j < 4; ++j) { const int n = (lane >> 3) + 8 * j; const LAS float* s = scr + (8 * c) * 33 + n;
        u32x4 o; o.x = cvt_pk_bf16(s[0 * 33] * ga[0], s[1 * 33] * ga[1]); o.y = cvt_pk_bf16(s[2 * 33] * ga[2], s[3 * 33] * ga[3]); o.z = cvt_pk_bf16(s[4 * 33] * gb[0], s[5 * 33] * gb[1]); o.w = cvt_pk_bf16(s[6 * 33] * gb[2], s[7 * 33] * gb[3]);
        *(GAS u32x4*)(WT + (size_t)rm(n0 + n) * K + k0 + 8 * c) = o; }
    asm volatile("s_waitcnt lgkmcnt(0)" ::: "memory");
}
struct RmId { __device__ __forceinline__ int operator()(int n) const { return n; } };
struct RmIn { __device__ __forceinline__ int operator()(int F) const { const int f = F & 255; return (F & ~255) + 128 * ((f >> 5) & 1) + 32 * (f >> 6) + (f & 31); } };
struct RmGU { int up; __device__ __forceinline__ int operator()(int h) const { return 256 * (h >> 7) + 128 * up + (h & 127); } };

struct S5n { double dt, lr, li; float cr, ci; };
__device__ __forceinline__ S5n s5_setup(const Args& A, const Frame& F, int g, int n) {
    S5n s; s.dt = (double)expf(A.in[17][g]); s.lr = (double)A.in[15][g * 64 + n]; s.li = (double)A.in[16][g * 64 + n];
    double ar, ai; abar_pow(1.0, s.dt, s.lr, s.li, ar, ai);
    const double nr = ar - 1.0, ni = ai, den = s.lr * s.lr + s.li * s.li;
    s.cr = (float)((nr * s.lr + ni * s.li) / den); s.ci = (float)((ni * s.lr - nr * s.li) / den);
    return s;
}
__device__ __forceinline__ void p0_tmat_task(const Args& A, const Frame& F, int task, LAS float* scr) {
    const int g = task >> 4, c = task & 15, n = F.lane;
    const S5n s = s5_setup(A, F, g, n);
    const float Cr = A.in[20][(g * 16 + c) * 64 + n], Ci = A.in[21][(g * 16 + c) * 64 + n];
    float br[16], bi[16];
#pragma unroll
    for (int cp = 0; cp < 16; ++cp) { const float xr = A.in[18][(g * 64 + n) * 16 + cp], xi = A.in[19][(g * 64 + n) * 16 + cp]; br[cp] = s.cr * xr - s.ci * xi; bi[cp] = s.cr * xi + s.ci * xr; }
    const float dsk = A.in[22][g * 16 + c];
    bf16_t* T = WSP(bf16_t, WS_TMAT) + (size_t)g * 256 * KA;
    double a1r, a1i; abar_pow(1.0, s.dt, s.lr, s.li, a1r, a1i);
    double pr = 1.0, pi = 0.0;
#pragma unroll 1
    for (int j = 0; j < 16; ++j) {
        const float wr_ = (float)pr, wi_ = (float)pi, cwr = Cr * wr_ - Ci * wi_, cwi = Cr * wi_ + Ci * wr_;
#pragma unroll
        for (int cp = 0; cp < 16; ++cp) { float v = wave_sum(cwr * br[cp] - cwi * bi[cp]); if (j == 0 && cp == c) v += dsk; if (n == 0) scr[j * 16 + cp] = v; }
        const double qr = pr * a1r - pi * a1i, qi = pr * a1i + pi * a1r; pr = qr; pi = qi;
        const float q_r = (float)qr, q_i = (float)qi;
        bf16_t* row = T + (size_t)(j * 16 + c) * KA;
        row[256 + n] = (bf16_t)(cvt_pk_bf16(Cr * q_r - Ci * q_i, 0.f) & 0xffffu);
        row[320 + n] = (bf16_t)(cvt_pk_bf16(-(Cr * q_i + Ci * q_r), 0.f) & 0xffffu);
    }
    asm volatile("s_waitcnt lgkmcnt(0)" ::: "memory");
    for (int t = 0; t < 16; ++t) {
        const int sidx = n >> 2, c0 = (n & 3) * 4, j = t - sidx; float v[4];
#pragma unroll
        for (int e = 0; e < 4; ++e) v[e] = (j >= 0) ? scr[(j < 0 ? 0 : j) * 16 + c0 + e] : 0.f;
        u32x2 w; w.x = cvt_pk_bf16(v[0], v[1]); w.y = cvt_pk_bf16(v[2], v[3]);
        *(u32x2*)(T + (size_t)(t * 16 + c) * KA + 4 * n) = w;
    }
    asm volatile("s_waitcnt lgkmcnt(0)" ::: "memory");
}
__device__ __forceinline__ void p0_wend_task(const Args& A, const Frame& F, int task) {
    const int g = task >> 4, sidx = task & 15, n = F.lane;
    const S5n s = s5_setup(A, F, g, n);
    double pr, pi; abar_pow((double)(15 - sidx), s.dt, s.lr, s.li, pr, pi);
    const float wr_ = (float)pr, wi_ = (float)pi;
    float re[16], im[16];
#pragma unroll
    for (int cp = 0; cp < 16; ++cp) { const float xr = A.in[18][(g * 64 + n) * 16 + cp], xi = A.in[19][(g * 64 + n) * 16 + cp]; const float br = s.cr * xr - s.ci * xi, bi = s.cr * xi + s.ci * xr;
        re[cp] = wr_ * br - wi_ * bi; im[cp] = wr_ * bi + wi_ * br; }
    bf16_t* W = WSP(bf16_t, WS_WEND) + (size_t)g * 256 * 256;
    u32x4 a, b;
    a.x = cvt_pk_bf16(re[0], re[1]); a.y = cvt_pk_bf16(re[2], re[3]); a.z = cvt_pk_bf16(re[4], re[5]); a.w = cvt_pk_bf16(re[6], re[7]);
    b.x = cvt_pk_bf16(re[8], re[9]); b.y = cvt_pk_bf16(re[10], re[11]); b.z = cvt_pk_bf16(re[12], re[13]); b.w = cvt_pk_bf16(re[14], re[15]);
    *(u32x4*)(W + (size_t)n * 256 + sidx * 16) = a; *(u32x4*)(W + (size_t)n * 256 + sidx * 16 + 8) = b;
    a.x = cvt_pk_bf16(im[0], im[1]); a.y = cvt_pk_bf16(im[2], im[3]); a.z = cvt_pk_bf16(im[4], im[5]); a.w = cvt_pk_bf16(im[6], im[7]);
    b.x = cvt_pk_bf16(im[8], im[9]); b.y = cvt_pk_bf16(im[10], im[11]); b.z = cvt_pk_bf16(im[12], im[13]); b.w = cvt_pk_bf16(im[14], im[15]);
    *(u32x4*)(W + (size_t)(64 + n) * 256 + sidx * 16) = a; *(u32x4*)(W + (size_t)(64 + n) * 256 + sidx * 16 + 8) = b;
}
__device__ __forceinline__ void p0_prologue(const Args& A, Frame& F) {
    LAS float* scr = (LAS float*)(F.lds + F.wave * 16384);
    for (int i = F.vcu * (NWAVES * 64) + F.tid; i < M * 2 / 4; i += F.G * NWAVES * 64) *(f32x4*)(WSP(float, WS_STAT) + 4 * (size_t)i) = (f32x4){0.f, 0.f, 0.f, 0.f};
    const int gw = F.vcu * NWAVES + F.wave, NGW = F.G * NWAVES;
    constexpr int I_ADA = 16 * 192, I_CS = 256;
    for (int it = gw; it < I_CS + I_ADA; it += NGW) {
        int r = it;
        if (r < I_CS) {
            const float* cr = r < 2 ? A.in[6] + (size_t)r * D : (r < NMODROWS ? A.in[7] + (size_t)(r - 2) * D : nullptr);
            bf16_t* o = WSP(bf16_t, WS_CS) + (size_t)r * D;
#pragma unroll
            for (int j = 0; j < 4; ++j) { f32x4 v = {0.f, 0.f, 0.f, 0.f}; if (cr) { v = *(const f32x4*)(cr + 4 * (F.lane + 64 * j)); v[0] = siluf_(v[0]); v[1] = siluf_(v[1]); v[2] = siluf_(v[2]); v[3] = siluf_(v[3]); }
                u32x2 w; w.x = cvt_pk_bf16(v[0], v[1]); w.y = cvt_pk_bf16(v[2], v[3]); *(u32x2*)(o + 4 * (F.lane + 64 * j)) = w; }
            continue; } r -= I_CS;
        p0_transpose_item(A.in[10], D, NMOD, WSP(bf16_t, WS_WADA), RmId{}, scr, r, F.lane);
    }
}
__device__ __forceinline__ void p1_side_work(const Args& A, Frame& F, int rank, int nranks) {
    LAS float* scr = (LAS float*)(F.lds + F.wave * 16384);
    const int gw = rank * NWAVES + F.wave, NGW = nranks * NWAVES;
    constexpr int I_IN = 16 * 64, I_GLU = 8 * 16, I_OUT = 16 * 32, I_G = 16 * 88, I_DN = 44 * 32, I_TM = 512, I_WE = 512;
    constexpr int NITEMS = I_IN + I_GLU + I_OUT + 2 * I_G + I_DN + I_TM + I_WE;
    for (int it = gw; it < NITEMS; it += NGW) {
        int r = it;
        if (r < I_TM) { p0_tmat_task(A, F, r, scr); continue; } r -= I_TM;
        if (r < I_WE) { p0_wend_task(A, F, r); continue; } r -= I_WE;
        if (r < I_IN) { p0_transpose_item(A.in[12], D, NIN, WSP(bf16_t, WS_WIN), RmIn{}, scr, r, F.lane); continue; } r -= I_IN;
        if (r < I_GLU) { p0_transpose_item(A.in[23], 512, 512, WSP(bf16_t, WS_WGLU), RmId{}, scr, r, F.lane); continue; } r -= I_GLU;
        if (r < I_OUT) { const int kb = r / 32;
            p0_transpose_item(A.in[26], D, D, WSP(bf16_t, WS_WOUT), RmId{}, scr, r, F.lane, kb < 8 ? A.in[24] : A.in[25] - 512); continue; } r -= I_OUT;
        if (r < I_G) { p0_transpose_item(A.in[27], D, FF, WSP(bf16_t, WS_WGU), RmGU{0}, scr, r, F.lane); continue; } r -= I_G;
        if (r < I_G) { p0_transpose_item(A.in[28], D, FF, WSP(bf16_t, WS_WGU), RmGU{1}, scr, r, F.lane); continue; } r -= I_G;
        p0_transpose_item(A.in[29], FF, D, WSP(bf16_t, WS_WDN), RmId{}, scr, r, F.lane);
    }
    { const int gt = rank * (NWAVES * 64) + F.tid, NT = nranks * NWAVES * 64;
      for (int i = gt; i < 32 * 128 * 32; i += NT) { const int g = i >> 12, rem = i & 4095; *(u32x4*)(WSP(bf16_t, WS_WEND) + (size_t)g * 65536 + 128 * 256 + (size_t)rem * 8) = (u32x4){0u, 0u, 0u, 0u}; } }
}

constexpr int CP_NRUN = 2 * 128 * 96, CP_PART = 32, CP_NPART = CP_NRUN / CP_PART;
__device__ __forceinline__ void copy_half_run(const Args& A, int R, int half, int lane) {
    const int tz = R >= 12288 ? 1 : 0, r = R - 12288 * tz, b = r / 96, run = r - 96 * b;
    const size_t off = ((size_t)b * 2048 + 16 * run) * 2048 + (size_t)half * 12288;
    const char* src = (const char*)(tz ? A.in[3] : A.in[2]) + off + 4 * 2048 + lane * 16; char* dst = (char*)(A.out + (tz ? OFF_VS : OFF_KS)) + off + lane * 16;
    u32x4 v[12];
#pragma unroll
    for (int j = 0; j < 12; ++j) v[j] = __builtin_nontemporal_load((const u32x4*)(src + j * 1024));
#pragma unroll
    for (int j = 0; j < 12; ++j) __builtin_nontemporal_store(v[j], (u32x4*)(dst + j * 1024));
}
__device__ __forceinline__ void stream_copy(const Args& A, Frame& F, unsigned* done, unsigned target) {
    LAS int* L = (LAS int*)(F.lds + LDSCTL_OFF);
    unsigned* gctr = (unsigned*)(A.ws + WS_CTL) + CW_CPCTR;
    if (F.tid == 0) L[9] = 0;
    __syncthreads();
    for (;;) {
        if (L[10]) break;
        if (L[0] == 0) {
            __syncthreads();
            if (F.tid == 0) { const unsigned p = __hip_atomic_fetch_add(gctr, 1u, __ATOMIC_RELAXED, __HIP_MEMORY_SCOPE_AGENT); if (p < (unsigned)CP_NPART) L[0] = (int)p + 1; else L[10] = 1; }
            if (F.tid < 8) L[1 + F.tid] = 0;
            __syncthreads();
            if (L[10]) break;
        }
        const int part = __builtin_amdgcn_readfirstlane(L[0]) - 1;
        int c = __builtin_amdgcn_readfirstlane(L[1 + F.wave]);
        while (c < 8) {
            if (done) {
                if (F.wave == 0 && F.lane == 0 && __hip_atomic_load(done + 64 * (F.vcu & 7), __ATOMIC_RELAXED, __HIP_MEMORY_SCOPE_AGENT) >= target) L[9] = 1;
                if (__builtin_amdgcn_readfirstlane(L[9])) break;
            }
            copy_half_run(A, part * CP_PART + F.wave + 8 * (c >> 1), c & 1, F.lane); ++c;
        }
        if (F.lane == 0) L[1 + F.wave] = c;
        if (done && F.wave == 0) {
            for (;;) { bool all = true;
#pragma unroll
                for (int w = 1; w < 8; ++w) all = all && (__builtin_amdgcn_readfirstlane(L[1 + w]) == 8);
                if (all || __builtin_amdgcn_readfirstlane(L[9])) break;
                if (F.lane == 0 && __hip_atomic_load(done + 64 * (F.vcu & 7), __ATOMIC_RELAXED, __HIP_MEMORY_SCOPE_AGENT) >= target) L[9] = 1;
                __builtin_amdgcn_s_sleep(8); }
        }
        __syncthreads();
        if (L[9]) break;
        if (F.tid == 0) L[0] = 0;
        __syncthreads();
    }
    __syncthreads();
}
__device__ __forceinline__ void signal_done(const Args& A, Frame& F, int k) {
    asm volatile("s_waitcnt vmcnt(0)" ::: "memory"); __syncthreads();
    if (F.tid < 8) __hip_atomic_fetch_add((unsigned*)(A.ws + WS_CTL) + CW_DONE + 512 * k + 64 * F.tid, 1u, __ATOMIC_RELAXED, __HIP_MEMORY_SCOPE_AGENT);
}
#define DONE_WORD(k) ((unsigned*)(A.ws + WS_CTL) + CW_DONE + 512 * (k))

__device__ __forceinline__ void wait_done(const Args& A, Frame& F, int k, unsigned target) {
    __syncthreads();
    if (F.tid == 0) { unsigned sp = 0; unsigned* dw = DONE_WORD(k) + 64 * (F.vcu & 7); unsigned* tmo = (unsigned*)(A.ws + WS_CTL) + CW_BAR + XB_TMO;
        while (__hip_atomic_load(dw, __ATOMIC_RELAXED, __HIP_MEMORY_SCOPE_AGENT) < target) { __builtin_amdgcn_s_sleep(2);
            if ((++sp & 255u) == 0u) { if (xb_ld(tmo)) break; if (sp > XB_SPIN_CAP) { atomicAdd(tmo, 1u); break; } } } }
    __syncthreads();
    __builtin_amdgcn_fence(__ATOMIC_ACQUIRE, "agent"); asm volatile("s_waitcnt vmcnt(0)" ::: "memory");
}
__device__ __forceinline__ void norm_mod_pass(const Args& A, Frame& F, const float* xp, const float* xs, const float* gain, int sh_off, int sc_off, bf16_t* XN, int row0, int row1, int gw, int NGW, const bool wthru = false) {
    const float* MOD = WSP(float, WS_MOD);
    for (int row = row0 + gw; row < row1; row += NGW) {
        const float* xr = row < MP ? xp + (size_t)row * D : xs + (size_t)(row - MP) * D; const float* mr = MOD + (size_t)mod_row(row) * NMOD;
        f32x4 v[4]; float s = 0.f;
#pragma unroll
        for (int j = 0; j < 4; ++j) { v[j] = *(const f32x4*)(xr + 4 * (F.lane + 64 * j)); s += (v[j][0] * v[j][0] + v[j][1] * v[j][1]) + (v[j][2] * v[j][2] + v[j][3] * v[j][3]); }
        const float rs = __builtin_amdgcn_rsqf(wave_sum(s) * (1.0f / D) + EPS);
#pragma unroll
        for (int j = 0; j < 4; ++j) { const int col = 4 * (F.lane + 64 * j);
            const f32x4 g = *(const f32x4*)(gain + col), sc = *(const f32x4*)(mr + sc_off + col), sh = *(const f32x4*)(mr + sh_off + col);
            const f32x4 h = v[j] * rs * g * (sc + 1.0f) + sh;
            u32x2 w; w.x = cvt_pk_bf16(h[0], h[1]); w.y = cvt_pk_bf16(h[2], h[3]);
            if (wthru) __builtin_amdgcn_raw_buffer_store_b64(w, __builtin_amdgcn_make_buffer_rsrc((void*)XN, 0, 0xffffffffu, 0x00020000), (int)(((unsigned)row * D + col) * 2u), 0, 16);
            else *(u32x2*)(XN + (size_t)row * D + col) = w; }
    }
}
__device__ __forceinline__ void merged_norm_pass(const Args& A, Frame& F) {
    const int gw = F.vcu * NWAVES + F.wave, NGW = F.G * NWAVES; const bf16_t* MRG = WSP(bf16_t, WS_MRG); bf16_t* O = WSP(bf16_t, WS_XN);
    for (int row = gw; row < M; row += NGW) {
        const u32x4 a = *(const u32x4*)(MRG + (size_t)row * D + 8 * F.lane), b = *(const u32x4*)(MRG + (size_t)row * D + 512 + 8 * F.lane);
        float av[8] = {bflo(a.x), bfhi(a.x), bflo(a.y), bfhi(a.y), bflo(a.z), bfhi(a.z), bflo(a.w), bfhi(a.w)};
        float bv[8] = {bflo(b.x), bfhi(b.x), bflo(b.y), bfhi(b.y), bflo(b.z), bfhi(b.z), bflo(b.w), bfhi(b.w)};
        float sa = 0.f, sb = 0.f;
#pragma unroll
        for (int e = 0; e < 8; ++e) { sa += av[e] * av[e]; sb += bv[e] * bv[e]; }
        const float ra = __builtin_amdgcn_rsqf(wave_sum(sa) * (1.0f / 512.0f) + EPS), rb = __builtin_amdgcn_rsqf(wave_sum(sb) * (1.0f / 512.0f) + EPS);
        const float* ga = A.in[24] + 8 * F.lane; const float* gs = A.in[25] + 8 * F.lane;
        const f32x4 ga0 = *(const f32x4*)ga, ga1 = *(const f32x4*)(ga + 4), gs0 = *(const f32x4*)gs, gs1 = *(const f32x4*)(gs + 4);
        u32x4 oa, ob;
        oa.x = cvt_pk_bf16(av[0] * ra * ga0[0], av[1] * ra * ga0[1]); oa.y = cvt_pk_bf16(av[2] * ra * ga0[2], av[3] * ra * ga0[3]);
        oa.z = cvt_pk_bf16(av[4] * ra * ga1[0], av[5] * ra * ga1[1]); oa.w = cvt_pk_bf16(av[6] * ra * ga1[2], av[7] * ra * ga1[3]);
        ob.x = cvt_pk_bf16(bv[0] * rb * gs0[0], bv[1] * rb * gs0[1]); ob.y = cvt_pk_bf16(bv[2] * rb * gs0[2], bv[3] * rb * gs0[3]);
        ob.z = cvt_pk_bf16(bv[4] * rb * gs1[0], bv[5] * rb * gs1[1]); ob.w = cvt_pk_bf16(bv[6] * rb * gs1[2], bv[7] * rb * gs1[3]);
        *(u32x4*)(O + (size_t)row * D + 8 * F.lane) = oa; *(u32x4*)(O + (size_t)row * D + 512 + 8 * F.lane) = ob;
    }
}

constexpr float NEGBIG = -1.0e30f;
constexpr int VROWB = 144;
constexpr int AT_ACC_OFF = 40960, AT_PITCH = 68, AT_L_OFF = AT_ACC_OFF + 256 * AT_PITCH * 4;
__device__ __forceinline__ s16x4 vtr(const LAS unsigned char* p) { typedef short v4i16_t __attribute__((ext_vector_type(4))); return __builtin_bit_cast(s16x4, __builtin_amdgcn_ds_read_tr16_b64_v4i16((LAS v4i16_t*)p)); }
struct AttnAcc { f32x4 O[4]; float l; };
__device__ __forceinline__ void attn_load_q(const bf16_t* Qb, size_t rowb, int h, int tq, float kmax, bf16x8 (&qf)[2], float& cshift, int lane) {
    const int g = lane >> 4;
    const bf16_t* qp = Qb + (rowb + tq) * 512 + h * 64 + 8 * g; qf[0] = *(const bf16x8*)qp; qf[1] = *(const bf16x8*)(qp + 32);
    float ss = 0.f;
#pragma unroll
    for (int e = 0; e < 8; ++e) { const float x = bf2f((unsigned short)qf[0][e]), y = bf2f((unsigned short)qf[1][e]); ss += x * x + y * y; }
    ss += __shfl_xor(ss, 16); ss += __shfl_xor(ss, 32);
    cshift = __builtin_sqrtf(ss) * kmax;
}
__device__ __forceinline__ void attn_blocks(const bf16_t* Kb, const bf16_t* Vb, size_t rowb, int h, const bf16x8 (&qf)[2], float cshift, AttnAcc& acc, int T0, int dil, int sq, int nblk, LAS unsigned char* vlds, int lane) {
    const int iq = lane & 15, g = lane >> 4, vrow = lane >> 3, vch = lane & 7;
    const LAS unsigned char* vrd = vlds + (4 * g + (iq >> 2)) * VROWB + (iq & 3) * 8;
    const int jjmin = -(T0 / dil);
    int ddmax = sq * iq - jjmin; ddmax = ddmax > 128 ? 128 : ddmax;
    const f32x4 cinit = {-cshift, -cshift, -cshift, -cshift};
#pragma unroll 1
    for (int kb = 0; kb < nblk; ++kb) {
        const int jj0 = -128 + 32 * kb;
        if (T0 + dil * (jj0 + 31) < 0) continue;
        bf16x8 kf[2][2];
#pragma unroll
        for (int tl = 0; tl < 2; ++tl) { int tok = T0 + dil * (jj0 + 16 * tl + iq); tok = tok < 0 ? 0 : (tok > SEQ - 1 ? SEQ - 1 : tok);
            const bf16_t* kp = Kb + (rowb + tok) * 512 + h * 64 + 8 * g; kf[tl][0] = *(const bf16x8*)kp; kf[tl][1] = *(const bf16x8*)(kp + 32); }
        u32x4 vreg[4];
#pragma unroll
        for (int rep = 0; rep < 4; ++rep) { int tok = T0 + dil * (jj0 + vrow + 8 * rep); tok = tok < 0 ? 0 : (tok > SEQ - 1 ? SEQ - 1 : tok);
            vreg[rep] = *(const u32x4*)(Vb + (rowb + tok) * 512 + h * 64 + 8 * vch); }
        f32x4 st[2];
#pragma unroll
        for (int tl = 0; tl < 2; ++tl) { st[tl] = __builtin_amdgcn_mfma_f32_16x16x32_bf16(kf[tl][0], qf[0], cinit, 0, 0, 0);
            st[tl] = __builtin_amdgcn_mfma_f32_16x16x32_bf16(kf[tl][1], qf[1], st[tl], 0, 0, 0); }
#pragma unroll
        for (int rep = 0; rep < 4; ++rep) *(LAS u32x4*)(vlds + (vrow + 8 * rep) * VROWB + vch * 16) = vreg[rep];
        const int base = sq * iq - 4 * g - jj0; float p[8]; float ps = 0.f;
#pragma unroll
        for (int j = 0; j < 8; ++j) { const int dd = base - (16 * (j >> 2) + (j & 3)); p[j] = ((unsigned)dd <= (unsigned)ddmax) ? fexp2(st[j >> 2][j & 3]) : 0.f; ps += p[j]; }
        acc.l += ps;
        bf16x8 pf; { u32x4 w; w.x = cvt_pk_bf16(p[0], p[1]); w.y = cvt_pk_bf16(p[2], p[3]); w.z = cvt_pk_bf16(p[4], p[5]); w.w = cvt_pk_bf16(p[6], p[7]); pf = __builtin_bit_cast(bf16x8, w); }
        asm volatile("s_waitcnt lgkmcnt(0)" ::: "memory");
#pragma unroll
        for (int d = 0; d < 4; ++d) {
            const s16x4 lo = vtr(vrd + d * 32), hi = vtr(vrd + d * 32 + 16 * VROWB);
            const bf16x8 vf = (bf16x8){lo[0], lo[1], lo[2], lo[3], hi[0], hi[1], hi[2], hi[3]};
            acc.O[d] = __builtin_amdgcn_mfma_f32_16x16x32_bf16(vf, pf, acc.O[d], 0, 0, 0);
        }
        asm volatile("s_waitcnt lgkmcnt(0)" ::: "memory");
    }
}
template <int DIL, int SQ, int NBLK, int OFFB>
__device__ __forceinline__ void attn_blocks2(const bf16_t* Kb, const bf16_t* Vb, size_t rowb, int h, const bf16x8 (&qfA)[2], float csA, AttnAcc& accA, const bf16x8 (&qfB)[2], float csB, AttnAcc& accB,
                                             int T0, LAS unsigned char* vlds, int lane) {
    const int iq = lane & 15, g = lane >> 4, vrow = lane >> 3, vch = lane & 7;
    const LAS unsigned char* vrd = vlds + (4 * g + (iq >> 2)) * VROWB + (iq & 3) * 8;
    const int jjmin = -(T0 / DIL);
    int ddmaxA = SQ * iq - jjmin; ddmaxA = ddmaxA > 128 ? 128 : ddmaxA;
    int ddmaxB = SQ * iq + OFFB - jjmin; ddmaxB = ddmaxB > 128 ? 128 : ddmaxB;
    const f32x4 cinitA = {-csA, -csA, -csA, -csA}, cinitB = {-csB, -csB, -csB, -csB};
#pragma unroll 1
    for (int kb = 0; kb < NBLK; ++kb) {
        const int jj0 = -128 + 32 * kb;
        if (T0 + DIL * (jj0 + 31) < 0) continue;
        bf16x8 kf[2][2];
#pragma unroll
        for (int tl = 0; tl < 2; ++tl) { int tok = T0 + DIL * (jj0 + 16 * tl + iq); tok = tok < 0 ? 0 : (tok > SEQ - 1 ? SEQ - 1 : tok);
            const bf16_t* kp = Kb + (rowb + tok) * 512 + h * 64 + 8 * g; kf[tl][0] = *(const bf16x8*)kp; kf[tl][1] = *(const bf16x8*)(kp + 32); }
        u32x4 vreg[4];
#pragma unroll
        for (int rep = 0; rep < 4; ++rep) { int tok = T0 + DIL * (jj0 + vrow + 8 * rep); tok = tok < 0 ? 0 : (tok > SEQ - 1 ? SEQ - 1 : tok);
            vreg[rep] = *(const u32x4*)(Vb + (rowb + tok) * 512 + h * 64 + 8 * vch); }
        f32x4 stA[2], stB[2];
#pragma unroll
        for (int tl = 0; tl < 2; ++tl) {
            stA[tl] = __builtin_amdgcn_mfma_f32_16x16x32_bf16(kf[tl][0], qfA[0], cinitA, 0, 0, 0); stA[tl] = __builtin_amdgcn_mfma_f32_16x16x32_bf16(kf[tl][1], qfA[1], stA[tl], 0, 0, 0);
            stB[tl] = __builtin_amdgcn_mfma_f32_16x16x32_bf16(kf[tl][0], qfB[0], cinitB, 0, 0, 0); stB[tl] = __builtin_amdgcn_mfma_f32_16x16x32_bf16(kf[tl][1], qfB[1], stB[tl], 0, 0, 0); }
#pragma unroll
        for (int rep = 0; rep < 4; ++rep) *(LAS u32x4*)(vlds + (vrow + 8 * rep) * VROWB + vch * 16) = vreg[rep];
        const int base = SQ * iq - 4 * g - jj0; float pA[8], pB[8]; float psA = 0.f, psB = 0.f;
#pragma unroll
        for (int j = 0; j < 8; ++j) { const int dd = base - (16 * (j >> 2) + (j & 3));
            pA[j] = ((unsigned)dd <= (unsigned)ddmaxA) ? fexp2(stA[j >> 2][j & 3]) : 0.f; psA += pA[j];
            pB[j] = ((unsigned)(dd + OFFB) <= (unsigned)ddmaxB) ? fexp2(stB[j >> 2][j & 3]) : 0.f; psB += pB[j]; }
        accA.l += psA; accB.l += psB;
        bf16x8 pfA, pfB;
        { u32x4 w; w.x = cvt_pk_bf16(pA[0], pA[1]); w.y = cvt_pk_bf16(pA[2], pA[3]); w.z = cvt_pk_bf16(pA[4], pA[5]); w.w = cvt_pk_bf16(pA[6], pA[7]); pfA = __builtin_bit_cast(bf16x8, w); }
        { u32x4 w; w.x = cvt_pk_bf16(pB[0], pB[1]); w.y = cvt_pk_bf16(pB[2], pB[3]); w.z = cvt_pk_bf16(pB[4], pB[5]); w.w = cvt_pk_bf16(pB[6], pB[7]); pfB = __builtin_bit_cast(bf16x8, w); }
        asm volatile("s_waitcnt lgkmcnt(0)" ::: "memory");
#pragma unroll
        for (int d = 0; d < 4; ++d) {
            const s16x4 lo = vtr(vrd + d * 32), hi = vtr(vrd + d * 32 + 16 * VROWB);
            const bf16x8 vf = (bf16x8){lo[0], lo[1], lo[2], lo[3], hi[0], hi[1], hi[2], hi[3]};
            accA.O[d] = __builtin_amdgcn_mfma_f32_16x16x32_bf16(vf, pfA, accA.O[d], 0, 0, 0);
            accB.O[d] = __builtin_amdgcn_mfma_f32_16x16x32_bf16(vf, pfB, accB.O[d], 0, 0, 0);
        }
        asm volatile("s_waitcnt lgkmcnt(0)" ::: "memory");
    }
}
__device__ __forceinline__ void prompt_attention(const Args& A, Frame& F, const int u0, const int du, const int nu, const int uextra) {
    const bf16_t* Qb = WSP(bf16_t, WS_Q); const bf16_t* Kb = WSP(bf16_t, WS_K); const bf16_t* Vb = WSP(bf16_t, WS_V); bf16_t* MRG = WSP(bf16_t, WS_MRG); float* STAT = WSP(float, WS_STAT);
    LAS unsigned char* vlds = F.lds + F.wave * 4608;
    LAS float* accl = (LAS float*)(F.lds + AT_ACC_OFF); LAS float* lacc = (LAS float*)(F.lds + AT_L_OFF);
    const int lane = F.lane, iq = lane & 15, g = lane >> 4;
    float kmax; { float x = fabsf(A.in[14][lane]);
#pragma unroll
        for (int o = 1; o < 64; o <<= 1) x = fmaxf(x, __shfl_xor(x, o));
        kmax = x * 8.0f * 1.01f; }
    for (int ku = 0; ku < nu + (uextra >= 0 ? 1 : 0); ++ku) {
        const int uu = ku < nu ? u0 + du * ku : uextra;
        const int blk = uu & 31, h = (uu >> 5) & 7, b = uu >> 8, Tb = blk * 256; const size_t rowb = (size_t)b * SEQ;
        { const int a = 2 * F.wave, TA = Tb + 16 * a;
            bf16x8 qfA[2], qfB[2]; float csA, csB; attn_load_q(Qb, rowb, h, TA + iq, kmax, qfA, csA, lane); attn_load_q(Qb, rowb, h, TA + 16 + iq, kmax, qfB, csB, lane);
            AttnAcc accA, accB; accA.l = 0.f; accB.l = 0.f;
#pragma unroll
            for (int d = 0; d < 4; ++d) { accA.O[d] = (f32x4){0.f, 0.f, 0.f, 0.f}; accB.O[d] = (f32x4){0.f, 0.f, 0.f, 0.f}; }
            attn_blocks2<1, 1, 6, 16>(Kb, Vb, rowb, h, qfA, csA, accA, qfB, csB, accB, TA, vlds, lane);
            float lA = accA.l, lB = accB.l; lA += __shfl_xor(lA, 16); lA += __shfl_xor(lA, 32); lB += __shfl_xor(lB, 16); lB += __shfl_xor(lB, 32);
            LAS float* ap = accl + (16 * a + iq) * AT_PITCH + 4 * g;
#pragma unroll
            for (int d = 0; d < 4; ++d) { *(LAS f32x4*)(ap + 16 * d) = accA.O[d]; *(LAS f32x4*)(ap + 16 * AT_PITCH + 16 * d) = accB.O[d]; }
            if (g == 0) { lacc[16 * a + iq] = lA; lacc[16 * a + 16 + iq] = lB; }
        }
        __syncthreads();
        { const int r = F.wave;
            bf16x8 qfA[2], qfB[2]; float csA, csB; attn_load_q(Qb, rowb, h, Tb + r + 16 * iq, kmax, qfA, csA, lane); attn_load_q(Qb, rowb, h, Tb + r + 8 + 16 * iq, kmax, qfB, csB, lane);
            AttnAcc accA, accB; accA.l = 0.f; accB.l = 0.f;
#pragma unroll
            for (int d = 0; d < 4; ++d) { accA.O[d] = (f32x4){0.f, 0.f, 0.f, 0.f}; accB.O[d] = (f32x4){0.f, 0.f, 0.f, 0.f}; }
            attn_blocks2<4, 4, 6, 2>(Kb, Vb, rowb, h, qfA, csA, accA, qfB, csB, accB, Tb + r, vlds, lane);
            attn_blocks(Kb, Vb, rowb, h, qfA, csA, accA, Tb + r, 16, 1, 5, vlds, lane);
            attn_blocks(Kb, Vb, rowb, h, qfB, csB, accB, Tb + r + 8, 16, 1, 5, vlds, lane);
            float lA = accA.l, lB = accB.l; lA += __shfl_xor(lA, 16); lA += __shfl_xor(lA, 32); lB += __shfl_xor(lB, 16); lB += __shfl_xor(lB, 32);
            LAS float* ap = accl + (r + 16 * iq) * AT_PITCH + 4 * g;
#pragma unroll
            for (int d = 0; d < 4; ++d) { const f32x4 o = *(LAS f32x4*)(ap + 16 * d); *(LAS f32x4*)(ap + 16 * d) = o + accA.O[d];
                const f32x4 o2 = *(LAS f32x4*)(ap + 8 * AT_PITCH + 16 * d); *(LAS f32x4*)(ap + 8 * AT_PITCH + 16 * d) = o2 + accB.O[d]; }
            if (g == 0) { lacc[r + 16 * iq] += lA; lacc[r + 8 + 16 * iq] += lB; }
        }
        __syncthreads();
        { const int q = F.tid >> 1, half = F.tid & 1; const float inv = 1.0f / lacc[q]; const LAS float* ap = accl + q * AT_PITCH + 32 * half;
          bf16_t* op = MRG + (rowb + Tb + q) * 1024 + h * 64 + 32 * half; float ss = 0.f;
#pragma unroll
          for (int kk = 0; kk < 4; ++kk) { const f32x4 x = *(const LAS f32x4*)(ap + 8 * kk) * inv, y = *(const LAS f32x4*)(ap + 8 * kk + 4) * inv; *(u32x4*)(op + 8 * kk) = pack8(x, y);
#pragma unroll
              for (int e = 0; e < 4; ++e) ss += x[e] * x[e] + y[e] * y[e]; }
          ss += dpp_mov<0xB1>(ss);
          if (half == 0) atomicAdd(STAT + (rowb + Tb + q) * 2, ss); }
        __syncthreads();
    }
}

struct SAState { float m[4], l[4]; f32x4 o[4]; };
__device__ __forceinline__ float red16(float v) { return row16_sum(v); }
__device__ __forceinline__ void sa_accum(SAState& S, int t, float s, float mult, const f32x4& v) {
    const float mnew = fmaxf(S.m[t], s), alpha = fexp2(S.m[t] - mnew), pw = mult * fexp2(s - mnew);
    S.l[t] = S.l[t] * alpha + pw; S.o[t] = S.o[t] * alpha + v * pw; S.m[t] = mnew;
}
__device__ __forceinline__ void sample_attention(const Args& A, Frame& F, const int maxu) {
    const float* QS = WSP(float, WS_QS); bf16_t* MRG = WSP(bf16_t, WS_MRG);
    LAS float* mg = (LAS float*)F.lds;
    LAS int* QL = (LAS int*)(F.lds + LDSCTL_OFF);
    for (int nu_ = 0; nu_ < maxu; ++nu_) {
        if (F.tid == 0) QL[16] = (int)__hip_atomic_fetch_add((unsigned*)(A.ws + WS_CTL) + CW_QS, 1u, __ATOMIC_RELAXED, __HIP_MEMORY_SCOPE_AGENT);
        __syncthreads();
        const int uu = __builtin_amdgcn_readfirstlane(QL[16]);
        if (uu >= 256) break;
        const int bs = uu >> 1, hh = uu & 1, hl = F.lane >> 4, head = 4 * hh + hl, dq = 4 * (F.lane & 15);
        const int coff = head * 64 + dq;
        f32x4 q[4];
#pragma unroll
        for (int t = 0; t < 4; ++t) q[t] = *(const f32x4*)(QS + (size_t)(bs * 4 + t) * 512 + coff);
        SAState S;
#pragma unroll
        for (int t = 0; t < 4; ++t) { S.m[t] = NEGBIG; S.l[t] = 0.f; S.o[t] = (f32x4){0.f, 0.f, 0.f, 0.f}; }
        const float* ck = A.in[2] + (size_t)bs * KVB * 512 + coff; const float* cv = A.in[3] + (size_t)bs * KVB * 512 + coff;
        const float* nk = A.out + OFF_KS + ((size_t)bs * KVB + (KVB - 4)) * 512 + coff; const float* nv = A.out + OFF_VS + ((size_t)bs * KVB + (KVB - 4)) * 512 + coff;
        float* dk = A.out + OFF_KS + (size_t)bs * KVB * 512 + coff; float* dv = A.out + OFF_VS + (size_t)bs * KVB * 512 + coff;
        f32x4 ka[8], va[8], kb[8], vb[8];
#define SA_LOAD_A(i0_, KK, VV) do { _Pragma("unroll") for (int j = 0; j < 8; ++j) { int p = 1536 + F.wave + 8 * ((i0_) + j); if (p > 2051) p = 2051; \
                KK[j] = p < KVB ? *(const f32x4*)(ck + (size_t)p * 512) : *(const f32x4*)(nk + (size_t)(p - KVB) * 512); \
                VV[j] = p < KVB ? *(const f32x4*)(cv + (size_t)p * 512) : *(const f32x4*)(nv + (size_t)(p - KVB) * 512); } } while (0)
#define SA_PROC_A(i0_, KK, VV) do { \
            _Pragma("unroll") for (int j = 0; j < 8; ++j) { const int p = 1536 + F.wave + 8 * ((i0_) + j); if (p < KVB) { __builtin_nontemporal_store(KK[j], (f32x4*)(dk + (size_t)(p - 4) * 512)); __builtin_nontemporal_store(VV[j], (f32x4*)(dv + (size_t)(p - 4) * 512)); } } \
            _Pragma("unroll") for (int j = 0; j < 8; ++j) { const int p = 1536 + F.wave + 8 * ((i0_) + j); if (p <= 2051) { \
                _Pragma("unroll") for (int t = 0; t < 4; ++t) { const int dist = KVB + t - p; \
                    if (dist >= 0) { const int mult = (dist <= 128 ? 1 : 0) + (((dist & 3) == 0 && dist <= 512) ? 1 : 0) + ((dist & 15) == 0 ? 1 : 0); \
                        if (mult > 0) { const float s = red16(q[t][0] * KK[j][0] + q[t][1] * KK[j][1] + q[t][2] * KK[j][2] + q[t][3] * KK[j][3]); sa_accum(S, t, s, (float)mult, VV[j]); } } } } } } while (0)
        SA_LOAD_A(0, ka, va);
#pragma unroll 1
        for (int i0 = 0; i0 < 72; i0 += 16) {
            if (i0 + 8 < 72) SA_LOAD_A(i0 + 8, kb, vb);
            SA_PROC_A(i0, ka, va);
            if (i0 + 16 < 72) SA_LOAD_A(i0 + 16, ka, va);
            if (i0 + 8 < 72) SA_PROC_A(i0 + 8, kb, vb);
        }
#define SA_LOAD_B(i0_, KK, VV) do { _Pragma("unroll") for (int j = 0; j < 8; ++j) { const int idx = F.wave + 8 * ((i0_) + j), p = 16 * (idx >> 2) + (idx & 3); \
                KK[j] = *(const f32x4*)(ck + (size_t)p * 512); VV[j] = *(const f32x4*)(cv + (size_t)p * 512); } } while (0)
#define SA_PROC_B(i0_, KK, VV) do { \
            _Pragma("unroll") for (int j = 0; j < 8; ++j) { const int idx = F.wave + 8 * ((i0_) + j), p = 16 * (idx >> 2) + (idx & 3); \
                if (p >= 4) { __builtin_nontemporal_store(KK[j], (f32x4*)(dk + (size_t)(p - 4) * 512)); __builtin_nontemporal_store(VV[j], (f32x4*)(dv + (size_t)(p - 4) * 512)); } } \
            _Pragma("unroll") for (int j = 0; j < 8; ++j) { const int t = (F.wave + 8 * ((i0_) + j)) & 3;      \
                float s0 = 0.f; \
                _Pragma("unroll") for (int tt = 0; tt < 4; ++tt) if (tt == t) s0 = q[tt][0] * KK[j][0] + q[tt][1] * KK[j][1] + q[tt][2] * KK[j][2] + q[tt][3] * KK[j][3]; \
                const float s = red16(s0); \
                _Pragma("unroll") for (int tt = 0; tt < 4; ++tt) if (tt == t) sa_accum(S, tt, s, 1.0f, VV[j]); } } while (0)
        SA_LOAD_B(0, ka, va);
#pragma unroll 1
        for (int i0 = 0; i0 < 48; i0 += 16) {
            SA_LOAD_B(i0 + 8, kb, vb);
            SA_PROC_B(i0, ka, va);
            if (i0 + 16 < 48) SA_LOAD_B(i0 + 16, ka, va);
            SA_PROC_B(i0 + 8, kb, vb);
        }
#undef SA_LOAD_A
#undef SA_PROC_A
#undef SA_LOAD_B
#undef SA_PROC_B
#pragma unroll
        for (int t = 0; t < 4; ++t) { LAS float* p = mg + ((F.wave * 4 + t) * 6) * 64 + F.lane; p[0] = S.m[t]; p[64] = S.l[t]; p[128] = S.o[t][0]; p[192] = S.o[t][1]; p[256] = S.o[t][2]; p[320] = S.o[t][3]; }
        __syncthreads();
        if (F.wave < 4) { const int t = F.wave; float mm = NEGBIG;
#pragma unroll
            for (int w = 0; w < 8; ++w) mm = fmaxf(mm, mg[((w * 4 + t) * 6) * 64 + F.lane]);
            float L = 0.f; f32x4 o = {0.f, 0.f, 0.f, 0.f};
#pragma unroll
            for (int w = 0; w < 8; ++w) { const LAS float* p = mg + ((w * 4 + t) * 6) * 64 + F.lane; const float f = fexp2(p[0] - mm); L += p[64] * f; o[0] += p[128] * f; o[1] += p[192] * f; o[2] += p[256] * f; o[3] += p[320] * f; }
            const float inv = 1.0f / L; u32x2 w2; w2.x = cvt_pk_bf16(o[0] * inv, o[1] * inv); w2.y = cvt_pk_bf16(o[2] * inv, o[3] * inv);
            *(u32x2*)(MRG + (size_t)(MP + bs * 4 + t) * 1024 + coff) = w2;
            const float ss = row16_sum((o[0] * o[0] + o[1] * o[1] + o[2] * o[2] + o[3] * o[3]) * inv * inv);
            if ((F.lane & 15) == 0) atomicAdd(WSP(float, WS_STAT) + (size_t)(MP + bs * 4 + t) * 2, ss); }
        __syncthreads();
    }
}

__device__ __forceinline__ void sample_s5(const Args& A, Frame& F) {
    const int gw = F.vcu * NWAVES + F.wave, NGW = F.G * NWAVES, n = F.lane; const float* US = WSP(float, WS_US); bf16_t* YG = WSP(bf16_t, WS_YG);
    for (int task = gw; task < 128 * 32; task += NGW) {
        const int bs = task >> 5, g = task & 31;
        const S5n s = s5_setup(A, F, g, n);
        double ar, ai; abar_pow(1.0, s.dt, s.lr, s.li, ar, ai); const float a_r = (float)ar, a_i = (float)ai;
        float hr = A.in[4][((size_t)bs * 32 + g) * 64 + n], hi = A.in[5][((size_t)bs * 32 + g) * 64 + n];
        const float uval = US[(size_t)(bs * 4 + (n >> 4)) * 512 + g * 16 + (n & 15)];
        float yv = 0.f;
#pragma unroll 1
        for (int t = 0; t < 4; ++t) {
            float bur = 0.f, bui = 0.f;
#pragma unroll
            for (int c = 0; c < 16; ++c) { const float u = rdlane(uval, t * 16 + c); const float xr = A.in[18][(g * 64 + n) * 16 + c], xi = A.in[19][(g * 64 + n) * 16 + c];
                bur += (s.cr * xr - s.ci * xi) * u; bui += (s.cr * xi + s.ci * xr) * u; }
            const float nr = a_r * hr - a_i * hi + bur, ni = a_r * hi + a_i * hr + bui; hr = nr; hi = ni;
#pragma unroll
            for (int c = 0; c < 16; ++c) { const float Cr = A.in[20][(g * 16 + c) * 64 + n], Ci = A.in[21][(g * 16 + c) * 64 + n];
                float y = wave_sum(Cr * hr - Ci * hi) + A.in[22][g * 16 + c] * rdlane(uval, t * 16 + c);
                y = gelu_tanh(y); if (n == t * 16 + c) yv = y; }
        }
        YG[(size_t)(MP + bs * 4 + (n >> 4)) * 512 + g * 16 + (n & 15)] = (bf16_t)(cvt_pk_bf16(yv, 0.f) & 0xffffu);
        A.out[OFF_HRS + ((size_t)bs * 32 + g) * 64 + n] = hr; A.out[OFF_HIS + ((size_t)bs * 32 + g) * 64 + n] = hi;
    }
}

__device__ __forceinline__ void s5_carry(const Args& A, Frame& F, const int b, const int g) {
    const int n = F.lane, w = F.wave;
    const S5n s = s5_setup(A, F, g, n);
    double ar, ai; abar_pow(16.0, s.dt, s.lr, s.li, ar, ai); const float a_r = (float)ar, a_i = (float)ai;
    double pr = ar, pi = ai;
#pragma unroll
    for (int k = 0; k < 6; ++k) { const double qr = pr * pr - pi * pi, qi = 2.0 * pr * pi; pr = qr; pi = qi; }
    const float A_r = (float)pr, A_i = (float)pi;
    bf16_t* AP = WSP(bf16_t, WS_AP); const float* SST = WSP(float, WS_SST);
    const size_t row0 = (size_t)g * 1024 + (size_t)b * 512 + (size_t)w * 64;
    float sr[64], si[64];
#pragma unroll
    for (int c = 0; c < 64; ++c) { sr[c] = SST[(row0 + c) * 128 + n]; si[c] = SST[(row0 + c) * 128 + 64 + n]; }
    float er = 0.f, ei = 0.f;
#pragma unroll
    for (int c = 0; c < 64; ++c) { const float nr = a_r * er - a_i * ei + sr[c], ni = a_r * ei + a_i * er + si[c]; er = nr; ei = ni; }
    LAS float* X = (LAS float*)F.lds;
    X[(w * 2) * 64 + n] = er; X[(w * 2 + 1) * 64 + n] = ei;
    __syncthreads();
    float hr = 0.f, hi = 0.f;
#pragma unroll
    for (int j = 0; j < 7; ++j) if (j < w) { const float xr = X[(j * 2) * 64 + n], xi = X[(j * 2 + 1) * 64 + n]; const float nr = A_r * hr - A_i * hi + xr, ni = A_r * hi + A_i * hr + xi; hr = nr; hi = ni; }
#pragma unroll
    for (int c = 0; c < 64; ++c) {
        AP[(row0 + c) * KA + 256 + n] = (bf16_t)(cvt_pk_bf16(hr, 0.f) & 0xffffu); AP[(row0 + c) * KA + 320 + n] = (bf16_t)(cvt_pk_bf16(hi, 0.f) & 0xffffu);
        const float nr = a_r * hr - a_i * hi + sr[c], ni = a_r * hi + a_i * hr + si[c]; hr = nr; hi = ni;
    }
    if (w == 7) { A.out[OFF_HRP + ((size_t)b * 32 + g) * 64 + n] = hr; A.out[OFF_HIP + ((size_t)b * 32 + g) * 64 + n] = hi; }
    __syncthreads();
}

constexpr int NPHASE = 13;
__global__ void __launch_bounds__(NWAVES * 64, 2) mk_fwd(Args args) {
    const Args& A = args;
    extern __shared__ __attribute__((aligned(16))) unsigned char lds_raw[];
    Frame F;
    F.lds = (LAS unsigned char*)lds_raw;
    F.tid = threadIdx.x; F.lane = F.tid & 63; F.wave = __builtin_amdgcn_readfirstlane(F.tid >> 6);
    F.G = gridDim.x; { const int bx = blockIdx.x; F.vcu = (F.G % 8 == 0) ? (bx % 8) * (F.G / 8) + bx / 8 : bx; }
    volatile LAS unsigned* MISC = (volatile LAS unsigned*)(F.lds + MISC_OFF);
    for (int u = F.tid; u < (LDS_BYTES - LDSCTL_OFF) / 4; u += NWAVES * 64) ((LAS unsigned*)(F.lds + LDSCTL_OFF))[u] = 0u;
    __syncthreads();
    unsigned* ctl = (unsigned*)(A.ws + WS_CTL);
    XcdBarrier bar; bar.bar = ctl + CW_BAR; bar.x = 0; bar.st = nullptr;
#if !MK_MULTI
    bar = xcd_barrier_post(ctl + CW_BAR, MISC + 8);
#define GRID_BAR() xcd_barrier(bar)
#else
#define GRID_BAR() do { } while (0)
#endif
    const int lo = args.ph_lo, hi = args.ph_hi;
#define IN(k) (lo <= (k) && (k) < hi)
#define BOTH(k) (IN(k) && IN((k) + 1))
    LAS unsigned char* ring = F.lds;

    if (IN(0)) { p0_prologue(A, F); if (BOTH(0)) GRID_BAR(); }
    if (IN(1)) {
        constexpr int GG = 24;
        if (F.vcu < GG) {
        pg8::StaticOrder S{(const char*)WSP(bf16_t, WS_CS), (const char*)WSP(bf16_t, WS_WADA), 1, NMOD / 256, GG, F.vcu, (size_t)256 * D * 2, (size_t)256 * D * 2};
        EpiMod E{WSP(float, WS_MOD), A.in[11]};
        pg8::gemm_phase<EpiMod, pg8::StaticOrder, true>(ring, D, D, D, S, E);
        } else p1_side_work(A, F, F.vcu - GG, F.G - GG);
        if (BOTH(1)) GRID_BAR();
    }
    if (IN(2)) { norm_mod_pass(A, F, A.in[0], A.in[1], A.in[8], 0, 1024, WSP(bf16_t, WS_XN), 0, M, F.vcu * NWAVES + F.wave, F.G * NWAVES); if (BOTH(2)) GRID_BAR(); }
    if (IN(3)) {
        { pg8::StaticOrder S{(const char*)WSP(bf16_t, WS_XN), (const char*)WSP(bf16_t, WS_WIN), MP / 256, NIN / 256, F.G, F.vcu, (size_t)256 * D * 2, (size_t)256 * D * 2};
        EpiIn E{WSP(bf16_t, WS_Q), WSP(bf16_t, WS_K), WSP(bf16_t, WS_V), WSP(bf16_t, WS_AP), WSP(float, WS_QS), WSP(float, WS_US), A.out, A.in[13], A.in[14]};
        pg8::gemm_phase<EpiIn, pg8::StaticOrder, true>(ring, D, D, D, S, E); }
        if (BOTH(3)) GRID_BAR();
    }
    if (IN(4)) {
        constexpr int NPW = 128, NSU = 2 * (NIN / 256);
        const bool roleA = F.vcu >= NPW; const int va = F.vcu - NPW; const bool proj = roleA && va < NSU;
        if (roleA) {
        { pg8::GroupOrder S{(const char*)WSP(bf16_t, WS_AP), (const char*)WSP(bf16_t, WS_WEND), 128, F.G - NPW, va, (size_t)256 * KA * 2, (size_t)256 * 256 * 2};
          EpiSt E{WSP(float, WS_SST)};
          pg8::gemm_phase<EpiSt, pg8::GroupOrder, true>(ring, 256, KA, 256, S, E); }
        asm volatile("s_waitcnt vmcnt(0)" ::: "memory"); __syncthreads();
        { unsigned* cw = (unsigned*)(A.ws + WS_CTL) + CW_S5C + 64 * (va >> 1);
          if (F.tid == 0) __hip_atomic_fetch_add(cw, 1u, __ATOMIC_RELAXED, __HIP_MEMORY_SCOPE_AGENT);
          if ((va & 1) == 0) {
              if (F.tid == 0) { unsigned sp = 0; unsigned* tmo = (unsigned*)(A.ws + WS_CTL) + CW_BAR + XB_TMO;
                  while (__hip_atomic_load(cw, __ATOMIC_RELAXED, __HIP_MEMORY_SCOPE_AGENT) < 2u) { __builtin_amdgcn_s_sleep(1);
                      if ((++sp & 255u) == 0u) { if (xb_ld(tmo)) break; if (sp > XB_SPIN_CAP) { atomicAdd(tmo, 1u); break; } } } }
              __syncthreads();
              __builtin_amdgcn_fence(__ATOMIC_ACQUIRE, "agent"); asm volatile("s_waitcnt vmcnt(0)" ::: "memory");
              s5_carry(A, F, (va >> 1) & 1, va >> 2);
          } }
        __syncthreads(); }
        if (proj) {
            pg8::StaticOrder S{(const char*)WSP(bf16_t, WS_XN), (const char*)WSP(bf16_t, WS_WIN), M / 256, NIN / 256, 1 << 20, (MP / 256) * (NIN / 256) + va, (size_t)256 * D * 2, (size_t)256 * D * 2};
            EpiIn E{WSP(bf16_t, WS_Q), WSP(bf16_t, WS_K), WSP(bf16_t, WS_V), WSP(bf16_t, WS_AP), WSP(float, WS_QS), WSP(float, WS_US), A.out, A.in[13], A.in[14]};
            pg8::gemm_phase<EpiIn, pg8::StaticOrder, true>(ring, D, D, D, S, E);
            signal_done(A, F, 4);
            __syncthreads();
        } else {
            prompt_attention(A, F, roleA ? 256 + va : F.vcu, 128, 2, F.vcu < 2 * NSU ? 256 + (F.vcu & (NSU - 1)) + 128 * (F.vcu >> 4) : -1);
            __syncthreads();
        }
        { if (F.tid == 0) { unsigned sp = 0; unsigned* dw = DONE_WORD(4) + 64 * (F.vcu & 7); unsigned* tmo = (unsigned*)(A.ws + WS_CTL) + CW_BAR + XB_TMO;
              while (__hip_atomic_load(dw, __ATOMIC_RELAXED, __HIP_MEMORY_SCOPE_AGENT) < 16u) { __builtin_amdgcn_s_sleep(2);
                  if ((++sp & 255u) == 0u) { if (xb_ld(tmo)) break; if (sp > XB_SPIN_CAP) { atomicAdd(tmo, 1u); break; } } } }
          __syncthreads();
          __builtin_amdgcn_fence(__ATOMIC_ACQUIRE, "agent"); asm volatile("s_waitcnt vmcnt(0)" ::: "memory"); }
        sample_attention(A, F, 1 << 30);
        sample_s5(A, F);
        if (BOTH(4)) GRID_BAR();
    }
    if (IN(6)) {
        constexpr int GG = 128;
        if (F.vcu < GG) {
        pg8::GroupOrder S{(const char*)WSP(bf16_t, WS_AP), (const char*)WSP(bf16_t, WS_TMAT), 128, GG, F.vcu, (size_t)256 * KA * 2, (size_t)256 * KA * 2};
        EpiY E{WSP(bf16_t, WS_YG)};
        pg8::gemm_phase<EpiY, pg8::GroupOrder, true>(ring, KA, KA, KA, S, E); }
        if (BOTH(6)) GRID_BAR();
    }
    if (IN(7)) {
        constexpr int GG = 132;
        if (F.vcu < GG) {
        pg8::StaticOrder S{(const char*)WSP(bf16_t, WS_YG), (const char*)WSP(bf16_t, WS_WGLU), M / 256, 2, GG, F.vcu, (size_t)256 * 512 * 2, (size_t)256 * 512 * 2};
        EpiGlu E{WSP(bf16_t, WS_YG), WSP(bf16_t, WS_MRG), WSP(float, WS_STAT)};
        pg8::gemm_phase<EpiGlu, pg8::StaticOrder, true>(ring, 512, 512, 512, S, E); }
        if (BOTH(7)) GRID_BAR();
    }
    if (IN(9)) {
        { pg8::StaticOrder S{(const char*)WSP(bf16_t, WS_MRG), (const char*)WSP(bf16_t, WS_WOUT), MP / 256, D / 256, F.G, F.vcu, (size_t)256 * D * 2, (size_t)256 * D * 2};
        EpiOut E{A.in[0], A.in[1], WSP(float, WS_MOD), WSP(float, WS_STAT), WSP(float, WS_X1)};
        pg8::gemm_phase<EpiOut, pg8::StaticOrder, true>(ring, D, D, D, S, E); }
        if (BOTH(9)) GRID_BAR();
    }
    if (IN(10)) { norm_mod_pass(A, F, WSP(float, WS_X1), WSP(float, WS_X1) + (size_t)MP * D, A.in[9], 3072, 4096, WSP(bf16_t, WS_XN), 0, MP, F.vcu * NWAVES + F.wave, F.G * NWAVES); if (BOTH(10)) GRID_BAR(); }
    if (IN(11)) {
        constexpr int GG = 242, NS = 14, NSO = 2 * (D / 256);
        if (F.vcu < GG) {
        pg8::StaticOrder S{(const char*)WSP(bf16_t, WS_XN), (const char*)WSP(bf16_t, WS_WGU), MP / 256, NGU / 256, GG, F.vcu, (size_t)256 * D * 2, (size_t)256 * D * 2};
        EpiGU E{WSP(bf16_t, WS_HB)};
        pg8::gemm_phase<EpiGU, pg8::StaticOrder, true>(ring, D, D, D, S, E); }
        else {
            const int r = F.vcu - GG;
            if (r < NSO) {
                pg8::StaticOrder S{(const char*)WSP(bf16_t, WS_MRG), (const char*)WSP(bf16_t, WS_WOUT), M / 256, D / 256, 1 << 20, (MP / 256) * (D / 256) + r, (size_t)256 * D * 2, (size_t)256 * D * 2};
                EpiOut E{A.in[0], A.in[1], WSP(float, WS_MOD), WSP(float, WS_STAT), WSP(float, WS_X1)};
                pg8::gemm_phase<EpiOut, pg8::StaticOrder, true>(ring, D, D, D, S, E);
                signal_done(A, F, 10);
            }
            wait_done(A, F, 10, NSO);
            norm_mod_pass(A, F, WSP(float, WS_X1), WSP(float, WS_X1) + (size_t)MP * D, A.in[9], 3072, 4096, WSP(bf16_t, WS_XN), MP, M, r * NWAVES + F.wave, NS * NWAVES, true);
            signal_done(A, F, 9);
            wait_done(A, F, 9, NS);
            { pg8::StaticOrder S{(const char*)WSP(bf16_t, WS_XN), (const char*)WSP(bf16_t, WS_WGU), M / 256, NGU / 256, NS, (MP / 256) * (NGU / 256) + r, (size_t)256 * D * 2, (size_t)256 * D * 2};
              EpiGU E{WSP(bf16_t, WS_HB)};
              pg8::gemm_phase<EpiGU, pg8::StaticOrder, true>(ring, D, D, D, S, E); }
        }
        if (BOTH(11)) GRID_BAR();
    }
    if (IN(12)) {
        constexpr int GG = 88;
        if (F.vcu < GG) {
        pg8::StaticOrder S{(const char*)WSP(bf16_t, WS_HB), (const char*)WSP(bf16_t, WS_WDN), M / 256, D / 256, GG, F.vcu, (size_t)256 * FF * 2, (size_t)256 * FF * 2};
        EpiDown E{WSP(float, WS_X1), WSP(float, WS_MOD), A.out};
        pg8::gemm_phase<EpiDown, pg8::StaticOrder, true>(ring, FF, FF, FF, S, E); }
        stream_copy(A, F, nullptr, 0u);
    }
#undef IN
#undef BOTH
}

extern "C" void kernel_launch(void* const* d_in, const int* in_sizes, int n_in, void* d_out, int out_size, void* d_ws, size_t ws_size, hipStream_t stream) {
    static int grid = 0;
    if (grid == 0) {
        if (n_in != 30 || ws_size < WS_END) { fprintf(stderr, "kernel_launch: unexpected n_in %d / ws %zu\n", n_in, ws_size); grid = -1; return; }
        int dev = 0, cus = 0;
        if (hipGetDevice(&dev) != hipSuccess || hipDeviceGetAttribute(&cus, hipDeviceAttributeMultiprocessorCount, dev) != hipSuccess) { grid = -1; return; }
        if (hipFuncSetAttribute((const void*)mk_fwd, hipFuncAttributeMaxDynamicSharedMemorySize, LDS_BYTES) != hipSuccess) { fprintf(stderr, "kernel_launch: hipFuncSetAttribute failed\n"); grid = -1; return; }
        int per_cu = 0;
        if (hipOccupancyMaxActiveBlocksPerMultiprocessor(&per_cu, (const void*)mk_fwd, NWAVES * 64, LDS_BYTES) != hipSuccess || per_cu < 1) fprintf(stderr, "kernel_launch: occupancy query says %d\n", per_cu);
        (void)hipGetLastError();
        grid = cus;
    }
    if (grid < 0) return;
    (void)hipMemsetAsync((char*)d_ws + WS_CTL, 0, CTL_ZERO_BYTES, stream);
    Args a{};
    for (int i = 0; i < 30; ++i) a.in[i] = (const float*)d_in[i];
    a.out = (float*)d_out; a.ws = (unsigned char*)d_ws;
#if MK_MULTI
    for (int p = 0; p < NPHASE; ++p) { a.ph_lo = p; a.ph_hi = p + 1; hipLaunchKernelGGL(mk_fwd, dim3(grid), dim3(NWAVES * 64), LDS_BYTES, stream, a); }
#else
    a.ph_lo = 0; a.ph_hi = NPHASE; hipLaunchKernelGGL(mk_fwd, dim3(grid), dim3(NWAVES * 64), LDS_BYTES, stream, a);
#endif
}
```

```cpp
#include <hip/hip_runtime.h>
#include <cstdio>
#include <cstdint>

#ifndef MK_MULTI
#define MK_MULTI 0
#endif

#define LAS __attribute__((address_space(3)))
#define GAS __attribute__((address_space(1)))
typedef unsigned short bf16_t;
typedef short bf16x8 __attribute__((ext_vector_type(8)));
typedef short s16x4 __attribute__((ext_vector_type(4)));
typedef float f32x4 __attribute__((ext_vector_type(4)));
typedef float f32x2 __attribute__((ext_vector_type(2)));
typedef unsigned u32x4 __attribute__((ext_vector_type(4)));
typedef unsigned u32x2 __attribute__((ext_vector_type(2)));

constexpr int D = 1024, SEQ = 8192, MP = 16384, MS = 512, M = MP + MS;
constexpr int KVB = 2048, NIN = 2048, FF = 2816, NMOD = 6144, NGU = 2 * FF;
constexpr int KA = 384;
constexpr int NMODROWS = 130;
constexpr float EPS = 1e-6f;
constexpr float LOG2E = 1.4426950408889634f;
constexpr float QSCALE = 0.125f * LOG2E;

constexpr size_t OFF_Y0 = 0, OFF_Y1 = 16777216, OFF_KP = 17301504, OFF_VP = 19398656, OFF_HRP = 21495808, OFF_HIP = 21499904,
                 OFF_KS = 21504000, OFF_VS = 155721728, OFF_HRS = 289939456, OFF_HIS = 290201600;

constexpr size_t MiB = 1u << 20;
constexpr size_t WS_CTL = 0, CTL_ZERO_BYTES = 1 * MiB;
constexpr size_t WS_WADA = 1 * MiB;
constexpr size_t WS_WIN = 13 * MiB;
constexpr size_t WS_WGLU = 17 * MiB;
constexpr size_t WS_WOUT = 18 * MiB;
constexpr size_t WS_WGU = 20 * MiB;
constexpr size_t WS_WDN = 31 * MiB;
constexpr size_t WS_TMAT = 37 * MiB;
constexpr size_t WS_WEND = 43 * MiB;
constexpr size_t WS_CS = 47 * MiB;
constexpr size_t WS_MOD = 48 * MiB;
constexpr size_t WS_XN = 52 * MiB;
constexpr size_t WS_Q = 86 * MiB;
constexpr size_t WS_K = 102 * MiB;
constexpr size_t WS_V = 118 * MiB;
constexpr size_t WS_QS = 134 * MiB;
constexpr size_t WS_US = 135 * MiB;
constexpr size_t WS_AP = 136 * MiB;
constexpr size_t WS_SST = 160 * MiB;
constexpr size_t WS_YG = 176 * MiB;
constexpr size_t WS_MRG = 193 * MiB;
constexpr size_t WS_X1 = 227 * MiB;
constexpr size_t WS_HB = 294 * MiB;
constexpr size_t WS_STAT = 385 * MiB;
constexpr size_t WS_END = 386 * MiB;
constexpr int CW_TMO = 0, CW_BAR = 4096;
constexpr int CW_S5C = 20480;
constexpr int CW_CPCTR = 8192, CW_QP = 8256, CW_QS = 8320, CW_DONE = 8448;

constexpr int RING_BYTES = 131072, LDSCTL_OFF = RING_BYTES, MISC_OFF = LDSCTL_OFF + 320, LDS_BYTES = 147456;
constexpr int NWAVES = 8;

__device__ __forceinline__ unsigned cvt_pk_bf16(float lo, float hi) { unsigned r; asm volatile("v_cvt_pk_bf16_f32 %0, %1, %2" : "=v"(r) : "v"(lo), "v"(hi)); return r; }
__device__ __forceinline__ float bf2f(unsigned short b) { return __uint_as_float((unsigned)b << 16); }
__device__ __forceinline__ float bflo(unsigned w) { return __uint_as_float(w << 16); }
__device__ __forceinline__ float bfhi(unsigned w) { return __uint_as_float(w & 0xffff0000u); }
template <int CTRL> __device__ __forceinline__ float dpp_mov(float v) { return __int_as_float(__builtin_amdgcn_update_dpp(0, __float_as_int(v), CTRL, 0xf, 0xf, true)); }
__device__ __forceinline__ float row16_sum(float v) {
    v += dpp_mov<0xB1>(v);
    v += dpp_mov<0x4E>(v);
    v += dpp_mov<0x141>(v);
    v += dpp_mov<0x140>(v);
    return v;
}
__device__ __forceinline__ float rdlane(float v, int l) { return __int_as_float(__builtin_amdgcn_readlane(__float_as_int(v), l)); }
__device__ __forceinline__ float wave_sum(float v) {
    v = row16_sum(v);
    return (rdlane(v, 0) + rdlane(v, 16)) + (rdlane(v, 32) + rdlane(v, 48));
}
__device__ __forceinline__ float fexp2(float x) { return __builtin_amdgcn_exp2f(x); }
__device__ __forceinline__ float frcp(float x) { return __builtin_amdgcn_rcpf(x); }
__device__ __forceinline__ float sigmoidf_(float x) { return frcp(1.0f + fexp2(-x * LOG2E)); }
__device__ __forceinline__ float siluf_(float x) { return x * sigmoidf_(x); }
__device__ __forceinline__ float gelu_tanh(float x) { const float z = 0.7978845608028654f * (x + 0.044715f * x * x * x); return x * frcp(1.0f + fexp2(-2.0f * LOG2E * z)); }
__device__ __forceinline__ u32x4 pack8(f32x4 a, f32x4 b) { u32x4 w; w.x = cvt_pk_bf16(a[0], a[1]); w.y = cvt_pk_bf16(a[2], a[3]); w.z = cvt_pk_bf16(b[0], b[1]); w.w = cvt_pk_bf16(b[2], b[3]); return w; }

__device__ __forceinline__ void wt16f(const void* base, unsigned off, f32x4 v) { __builtin_amdgcn_raw_buffer_store_b128(__builtin_bit_cast(u32x4, v), __builtin_amdgcn_make_buffer_rsrc((void*)base, 0, 0xffffffffu, 0x00020000), (int)off, 0, 16); }

__device__ __forceinline__ void wt16(const void* base, unsigned off, u32x4 v) { __builtin_amdgcn_raw_buffer_store_b128(v, __builtin_amdgcn_make_buffer_rsrc((void*)base, 0, 0xffffffffu, 0x00020000), (int)off, 0, 16); }
__device__ __forceinline__ double dexp_small(double x) {
    const double y = x * 0.125;
    double t = 1.0 + y * (1.0 / 12.0);
    t = 1.0 + t * y * (1.0 / 11.0); t = 1.0 + t * y * (1.0 / 10.0); t = 1.0 + t * y * (1.0 / 9.0); t = 1.0 + t * y * (1.0 / 8.0); t = 1.0 + t * y * (1.0 / 7.0); t = 1.0 + t * y * (1.0 / 6.0);
    t = 1.0 + t * y * (1.0 / 5.0); t = 1.0 + t * y * (1.0 / 4.0); t = 1.0 + t * y * (1.0 / 3.0); t = 1.0 + t * y * (1.0 / 2.0); t = 1.0 + t * y;
    t = t * t; t = t * t; t = t * t; return t;
}
__device__ __forceinline__ void dsincos(double a, double& s, double& c) {
    const double k = __builtin_rint(a * 0.63661977236758134308);
    const double y = (a - k * 1.57079632679489655800) - k * 6.123233995736766036e-17;
    const double y2 = y * y;
    const double sp = y * (1.0 + y2 * (-1.0 / 6 + y2 * (1.0 / 120 + y2 * (-1.0 / 5040 + y2 * (1.0 / 362880 + y2 * (-1.0 / 39916800 + y2 * (1.0 / 6227020800.0)))))));
    const double cp = 1.0 + y2 * (-0.5 + y2 * (1.0 / 24 + y2 * (-1.0 / 720 + y2 * (1.0 / 40320 + y2 * (-1.0 / 3628800 + y2 * (1.0 / 479001600.0 + y2 * (-1.0 / 87178291200.0)))))));
    const long long q = (long long)k & 3;
    s = (q == 0) ? sp : (q == 1) ? cp : (q == 2) ? -sp : -cp;
    c = (q == 0) ? cp : (q == 1) ? -sp : (q == 2) ? -cp : sp;
}
__device__ __forceinline__ void abar_pow(double j, double dt, double lr, double li, double& re, double& im) {
    const double mag = dexp_small(j * dt * lr); double s, c; dsincos(j * dt * li, s, c); re = mag * c; im = mag * s;
}

namespace pg8 {
constexpr int BM = 256, BK = 64, HALF = 128, HTB = HALF * BK * 2, STAGE_BYTES = 8 * HTB;
__host__ __device__ __forceinline__ int lds_byte(int r, int c) { const int st = (r >> 4) * 2 + (c >> 5), rr = r & 15, cc = c & 31, ob = rr * 64 + cc * 2; return st * 1024 + (ob ^ (((ob >> 9) & 1) << 5)); }
__host__ __device__ __forceinline__ void stage_rc(int b, int& R, int& C) { const int st = b / 1024, sb = b % 1024, swz = sb ^ (((sb >> 9) & 1) << 5); R = (st >> 1) * 16 + swz / 64; C = (st & 1) * 32 + (swz % 64) / 2; }
__host__ __device__ __forceinline__ int perm32(int rho) { const int n = rho >> 4, i = rho & 15; return 8 * (i >> 2) + 4 * n + (i & 3); }

struct Unit { int pm, pn; const char* a; const char* b; };

struct StaticOrder {
    const char* A; const char* B; int nM, nN, G, c; size_t strideA, strideB;
    __device__ __forceinline__ bool next(int i, Unit& u) const {
        const int L = i * G + c; if (L >= nM * nN) return false;
        u.pm = L / nN; u.pn = L - u.pm * nN; u.a = A + (size_t)u.pm * strideA; u.b = B + (size_t)u.pn * strideB; return true;
    }
};
struct GroupOrder {
    const char* A; const char* B; int nM, G, c; size_t strideA, strideB;
    __device__ __forceinline__ bool next(int i, Unit& u) const {
        const int L = i * G + c; if (L >= nM) return false;
        u.pm = L; u.pn = 0; u.a = A + (size_t)L * strideA; u.b = B + (size_t)(L >> 2) * strideB; return true;
    }
};

template <class Epi, class Sched, bool ALIGN_EPI>
__device__ __forceinline__ void gemm_phase(LAS unsigned char* lds, const int K, const int lda, const int ldb, const Sched& S, const Epi& E) {
    const int tid = threadIdx.x, wid = __builtin_amdgcn_readfirstlane(tid >> 6), lane = tid & 63, wr = wid >> 2, wc = wid & 3, fr = lane & 15, fq = lane >> 4;
    const int nt = K / BK;
    unsigned voffA[2], voffB[2];
#pragma unroll
    for (int i = 0; i < 2; ++i) { int R, C; stage_rc(tid * 16 + i * 8192, R, C); const int Rb = (R & ~31) + perm32(R & 31);
        voffA[i] = (unsigned)(R * lda + C) * 2u; voffB[i] = (unsigned)(Rb * ldb + C) * 2u; }
    const size_t kstep = (size_t)(BK * 2);
    const size_t hstepA = (size_t)HALF * lda * 2, hstepB = (size_t)HALF * ldb * 2;
    const unsigned ldsw = (unsigned)wid * 1024u;
    const int aoff = lds_byte(wr * 64 + fr, fq * 8), boff = lds_byte(wc * 32 + fr, fq * 8);
#define PG8_SA(b, h) (((b) * 2 + (h)) * HTB)
#define PG8_SB(b, h) ((4 + (b) * 2 + (h)) * HTB)
#define PG8_STAGE(bufoff, gbase, voff) do { _Pragma("unroll") for (int _i = 0; _i < 2; ++_i) { unsigned _vo = (voff)[_i]; asm volatile("" : "+v"(_vo)); \
        __builtin_amdgcn_global_load_lds((const unsigned*)((const char*)(gbase) + _vo), (LAS unsigned*)(lds + (bufoff) + ldsw + _i * 8192), 16, 0, 0); } } while (0)
#define PG8_LDA(dst, b, h) do { _Pragma("unroll") for (int m = 0; m < 4; ++m) _Pragma("unroll") for (int k = 0; k < 2; ++k) dst[m][k] = *(const LAS bf16x8*)(lds + PG8_SA(b, h) + aoff + m * 2048 + k * 1024); } while (0)
#define PG8_LDB(dst, b, h) do { _Pragma("unroll") for (int n = 0; n < 2; ++n) _Pragma("unroll") for (int k = 0; k < 2; ++k) dst[n][k] = *(const LAS bf16x8*)(lds + PG8_SB(b, h) + boff + n * 2048 + k * 1024); } while (0)
#define PG8_MMA(ai, bj, At, Bt) do { __builtin_amdgcn_s_setprio(1); _Pragma("unroll") for (int m = 0; m < 4; ++m) _Pragma("unroll") for (int n = 0; n < 2; ++n) _Pragma("unroll") for (int k = 0; k < 2; ++k) \
        acc[ai][bj][m][n] = __builtin_amdgcn_mfma_f32_16x16x32_bf16(Bt[n][k], At[m][k], acc[ai][bj][m][n], 0, 0, 0); __builtin_amdgcn_s_setprio(0); } while (0)
#define PG8_WAIT_V(n) asm volatile("s_waitcnt vmcnt(" #n ")" ::: "memory")
#define PG8_WAIT_L(n) asm volatile("s_waitcnt lgkmcnt(" #n ")" ::: "memory")
#define PG8_BAR __builtin_amdgcn_s_barrier()
#define PG8_SCHED __builtin_amdgcn_sched_barrier(0)
    Unit cur, nxt; int ui = 0;
    if (!S.next(0, cur)) return;
    f32x4 acc[2][2][4][2];
#pragma unroll
    for (int a = 0; a < 2; ++a)
#pragma unroll
        for (int b = 0; b < 2; ++b)
#pragma unroll
            for (int m = 0; m < 4; ++m)
#pragma unroll
                for (int n = 0; n < 2; ++n) acc[a][b][m][n] = (f32x4){0.f, 0.f, 0.f, 0.f};
    bf16x8 At[4][2], B0[2][2], B1[2][2];
    const char* cA = cur.a; const char* cB = cur.b;
    PG8_STAGE(PG8_SB(0, 0), cB, voffB); PG8_STAGE(PG8_SB(0, 1), cB + hstepB, voffB); PG8_STAGE(PG8_SA(0, 0), cA, voffA); PG8_STAGE(PG8_SA(0, 1), cA + hstepA, voffA);
    if (wr == 1) PG8_BAR;
    PG8_WAIT_V(2); PG8_BAR;
    PG8_STAGE(PG8_SB(1, 0), cB + kstep, voffB); PG8_STAGE(PG8_SA(1, 0), cA + kstep, voffA); PG8_STAGE(PG8_SB(1, 1), cB + hstepB + kstep, voffB);
    PG8_WAIT_V(6); PG8_BAR;
    for (;;) {
        const bool has_next = S.next(ui + 1, nxt);
        const char* nA = has_next ? nxt.a : cA; const char* nB = has_next ? nxt.b : cB;
        for (int t = 0; t < nt; t += 2) {
            if constexpr (Epi::MIDK) { if (t == (nt >> 1)) E.mid(acc, cur, wr, fr); }
            const bool last = (t == nt - 2);
            const char* a1 = cA + (size_t)(t + 1) * kstep;
            const char* a2 = last ? nA : cA + (size_t)(t + 2) * kstep; const char* b2 = last ? nB : cB + (size_t)(t + 2) * kstep;
            const char* a3 = a2 + kstep; const char* b3 = b2 + kstep;
            PG8_LDB(B0, 0, 0); PG8_LDB(B1, 0, 1); PG8_SCHED; PG8_LDA(At, 0, 0); PG8_STAGE(PG8_SA(1, 1), a1 + hstepA, voffA);
            PG8_WAIT_V(8); PG8_WAIT_L(0); PG8_BAR; PG8_MMA(0, 0, At, B0); PG8_MMA(0, 1, At, B1); PG8_BAR; PG8_SCHED;
            PG8_LDA(At, 0, 1); PG8_STAGE(PG8_SB(0, 0), b2, voffB); PG8_STAGE(PG8_SB(0, 1), b2 + hstepB, voffB); PG8_STAGE(PG8_SA(0, 0), a2, voffA);
            PG8_WAIT_V(8); PG8_WAIT_L(0); PG8_BAR; PG8_MMA(1, 0, At, B0); PG8_MMA(1, 1, At, B1); PG8_BAR; PG8_SCHED;
            PG8_LDB(B0, 1, 0); PG8_LDB(B1, 1, 1); PG8_SCHED; PG8_LDA(At, 1, 0); PG8_STAGE(PG8_SA(0, 1), a2 + hstepA, voffA);
            PG8_WAIT_V(8); PG8_WAIT_L(0); PG8_BAR; PG8_MMA(0, 0, At, B0); PG8_MMA(0, 1, At, B1); PG8_BAR; PG8_SCHED;
            PG8_LDA(At, 1, 1); PG8_STAGE(PG8_SB(1, 0), b3, voffB); PG8_STAGE(PG8_SB(1, 1), b3 + hstepB, voffB); PG8_STAGE(PG8_SA(1, 0), a3, voffA);
            PG8_WAIT_V(8); PG8_WAIT_L(0); PG8_BAR; PG8_MMA(1, 0, At, B0); PG8_MMA(1, 1, At, B1); PG8_BAR; PG8_SCHED;
        }
        if constexpr (ALIGN_EPI) { if (wr == 0) PG8_BAR; }
        E(acc, cur, wr, wc, fr, fq);
        if (!has_next) break;
#pragma unroll
        for (int a = 0; a < 2; ++a)
#pragma unroll
            for (int b = 0; b < 2; ++b)
#pragma unroll
                for (int m = 0; m < 4; ++m)
#pragma unroll
                    for (int n = 0; n < 2; ++n) acc[a][b][m][n] = (f32x4){0.f, 0.f, 0.f, 0.f};
        cur = nxt; cA = nA; cB = nB; ++ui;
        if constexpr (ALIGN_EPI) { if (wr == 1) PG8_BAR; }
    }
    PG8_WAIT_V(0);
    if constexpr (!ALIGN_EPI) { if (wr == 0) PG8_BAR; }
    PG8_BAR;
#undef PG8_SA
#undef PG8_SB
#undef PG8_STAGE
#undef PG8_LDA
#undef PG8_LDB
#undef PG8_MMA
#undef PG8_WAIT_V
#undef PG8_WAIT_L
#undef PG8_BAR
#undef PG8_SCHED
}
}
using pg8::Unit;
typedef f32x4 Acc[2][2][4][2];

__device__ __forceinline__ int mod_row(int row) { return row < MP ? (row >> 13) : 2 + ((row - MP) >> 2); }

struct EpiMod {
    static constexpr bool MIDK = false;
    float* MOD; const float* bada;
    __device__ __forceinline__ void operator()(const Acc& acc, const Unit& u, int wr, int wc, int fr, int fq) const {
        asm volatile("" : "+v"(fr), "+v"(fq));
#pragma unroll
        for (int ai = 0; ai < 2; ++ai)
#pragma unroll
            for (int m = 0; m < 4; ++m) { const int row = u.pm * 256 + ai * 128 + wr * 64 + m * 16 + fr;
                if (row < NMODROWS) {
#pragma unroll
                    for (int bj = 0; bj < 2; ++bj) { const int col = u.pn * 256 + bj * 128 + wc * 32 + 8 * fq;
                        const f32x4 b0 = *(const f32x4*)(bada + col), b1 = *(const f32x4*)(bada + col + 4);
                        *(f32x4*)(MOD + (size_t)row * NMOD + col) = acc[ai][bj][m][0] + b0; *(f32x4*)(MOD + (size_t)row * NMOD + col + 4) = acc[ai][bj][m][1] + b1; } } }
    }
};
struct EpiIn {
    static constexpr bool MIDK = false;
    bf16_t *Qb, *Kb, *Vb, *AP; float *QS, *US, *out; const float *qg, *kg;
    __device__ __forceinline__ void operator()(const Acc& acc, const Unit& u, int wr, int wc, int fr, int fq) const {
        asm volatile("" : "+v"(fr), "+v"(fq));
        const int kind = u.pn >> 1, half = u.pn & 1, head = 4 * half + wc;
        const bool prompt = u.pm < 64;
        f32x4 g00 = {1.f, 1.f, 1.f, 1.f}, g01 = g00, g10 = g00, g11 = g00;
        if (kind <= 1) { const float* gp = kind == 0 ? qg : kg; g00 = *(const f32x4*)(gp + 8 * fq); g01 = *(const f32x4*)(gp + 8 * fq + 4); g10 = *(const f32x4*)(gp + 32 + 8 * fq); g11 = *(const f32x4*)(gp + 32 + 8 * fq + 4); }
#pragma unroll
        for (int ai = 0; ai < 2; ++ai)
#pragma unroll
            for (int m = 0; m < 4; ++m) {
                const int row = u.pm * 256 + ai * 128 + wr * 64 + m * 16 + fr;
                f32x4 a0 = acc[ai][0][m][0], a1 = acc[ai][0][m][1], b0 = acc[ai][1][m][0], b1 = acc[ai][1][m][1];
                if (kind <= 1) {
                    float ss = 0.f;
#pragma unroll
                    for (int e = 0; e < 4; ++e) ss += a0[e] * a0[e] + a1[e] * a1[e] + b0[e] * b0[e] + b1[e] * b1[e];
                    ss += __shfl_xor(ss, 16); ss += __shfl_xor(ss, 32);
                    float rs = __builtin_amdgcn_rsqf(ss * (1.0f / 64.0f) + EPS);
                    if (kind == 0) rs *= QSCALE;
                    a0 = a0 * g00 * rs; a1 = a1 * g01 * rs; b0 = b0 * g10 * rs; b1 = b1 * g11 * rs;
                }
                const int c0 = head * 64 + 8 * fq;
                if (kind == 0) {
                    if (prompt) { *(u32x4*)(Qb + (size_t)row * 512 + c0) = pack8(a0, a1); *(u32x4*)(Qb + (size_t)row * 512 + c0 + 32) = pack8(b0, b1); }
                    else { const unsigned o_ = ((unsigned)(row - MP) * 512u + c0) * 4u; wt16f(QS, o_, a0); wt16f(QS, o_ + 16u, a1); wt16f(QS, o_ + 128u, b0); wt16f(QS, o_ + 144u, b1); }
                } else if (kind <= 2) {
                    bf16_t* Bb = kind == 1 ? Kb : Vb; float* o = out + (kind == 1 ? OFF_KP : OFF_VP); float* os = out + (kind == 1 ? OFF_KS : OFF_VS);
                    if (prompt) {
                        *(u32x4*)(Bb + (size_t)row * 512 + c0) = pack8(a0, a1); *(u32x4*)(Bb + (size_t)row * 512 + c0 + 32) = pack8(b0, b1);
                        const int b = row >> 13, t = row & 8191;
                        if (t >= SEQ - KVB) { float* p = o + ((size_t)b * KVB + (t - (SEQ - KVB))) * 512 + c0; *(f32x4*)p = a0; *(f32x4*)(p + 4) = a1; *(f32x4*)(p + 32) = b0; *(f32x4*)(p + 36) = b1; }
                    } else {
                        const int rs_ = row - MP, bs = rs_ >> 2, t = rs_ & 3;
                        const unsigned o_ = (((unsigned)bs * KVB + (KVB - 4) + t) * 512u + c0) * 4u; wt16f(os, o_, a0); wt16f(os, o_ + 16u, a1); wt16f(os, o_ + 128u, b0); wt16f(os, o_ + 144u, b1);
                    }
                } else {
                    if (prompt) {
                        const int g0 = 16 * half + 4 * wc + (fq >> 1), cc = 8 * (fq & 1);
                        bf16_t* p0 = AP + ((size_t)g0 * 1024 + (row >> 4)) * KA + (row & 15) * 16 + cc;
                        *(u32x4*)p0 = pack8(a0, a1); *(u32x4*)(p0 + (size_t)2 * 1024 * KA) = pack8(b0, b1);
                    } else { const unsigned o_ = ((unsigned)(row - MP) * 512u + c0) * 4u; wt16f(US, o_, a0); wt16f(US, o_ + 16u, a1); wt16f(US, o_ + 128u, b0); wt16f(US, o_ + 144u, b1); }
                }
            }
    }
};
struct EpiSt {
    static constexpr bool MIDK = false;
    float* SST;
    __device__ __forceinline__ void operator()(const Acc& acc, const Unit& u, int wr, int wc, int fr, int fq) const {
        asm volatile("" : "+v"(fr), "+v"(fq));
#pragma unroll
        for (int ai = 0; ai < 2; ++ai)
#pragma unroll
            for (int m = 0; m < 4; ++m) { const int row = u.pm * 256 + ai * 128 + wr * 64 + m * 16 + fr; const unsigned o_ = ((unsigned)row * 128u + wc * 32 + 8 * fq) * 4u;
                wt16f(SST, o_, acc[ai][0][m][0]); wt16f(SST, o_ + 16u, acc[ai][0][m][1]); }
    }
};
struct EpiY {
    static constexpr bool MIDK = false;
    bf16_t* YG;
    __device__ __forceinline__ void operator()(const Acc& acc, const Unit& u, int wr, int wc, int fr, int fq) const {
        asm volatile("" : "+v"(fr), "+v"(fq));
        const int g = u.pm >> 2;
#pragma unroll
        for (int ai = 0; ai < 2; ++ai)
#pragma unroll
            for (int m = 0; m < 4; ++m) { const int R = u.pm * 256 + ai * 128 + wr * 64 + m * 16 + fr, chunk = R & 1023;
#pragma unroll
                for (int bj = 0; bj < 2; ++bj) { const int tt = 8 * bj + 2 * wc + (fq >> 1), cc = 8 * (fq & 1);
                    f32x4 v0 = acc[ai][bj][m][0], v1 = acc[ai][bj][m][1];
#pragma unroll
                    for (int e = 0; e < 4; ++e) { v0[e] = gelu_tanh(v0[e]); v1[e] = gelu_tanh(v1[e]); }
                    *(u32x4*)(YG + (size_t)(chunk * 16 + tt) * 512 + g * 16 + cc) = pack8(v0, v1); } }
    }
};
struct EpiGlu {
    static constexpr bool MIDK = false;
    const bf16_t* YG; bf16_t* MRG; float* STAT;
    __device__ __forceinline__ void operator()(const Acc& acc, const Unit& u, int wr, int wc, int fr, int fq) const {
        asm volatile("" : "+v"(fr), "+v"(fq));
#pragma unroll
        for (int ai = 0; ai < 2; ++ai)
#pragma unroll
            for (int m = 0; m < 4; ++m) { const int row = u.pm * 256 + ai * 128 + wr * 64 + m * 16 + fr; float ss = 0.f;
#pragma unroll
                for (int bj = 0; bj < 2; ++bj) { const int col = u.pn * 256 + bj * 128 + wc * 32 + 8 * fq;
                    const u32x4 yw = *(const u32x4*)(YG + (size_t)row * 512 + col);
                    f32x4 v0 = acc[ai][bj][m][0], v1 = acc[ai][bj][m][1];
                    v0[0] = bflo(yw.x) * sigmoidf_(v0[0]); v0[1] = bfhi(yw.x) * sigmoidf_(v0[1]); v0[2] = bflo(yw.y) * sigmoidf_(v0[2]); v0[3] = bfhi(yw.y) * sigmoidf_(v0[3]);
                    v1[0] = bflo(yw.z) * sigmoidf_(v1[0]); v1[1] = bfhi(yw.z) * sigmoidf_(v1[1]); v1[2] = bflo(yw.w) * sigmoidf_(v1[2]); v1[3] = bfhi(yw.w) * sigmoidf_(v1[3]);
#pragma unroll
                    for (int e = 0; e < 4; ++e) ss += v0[e] * v0[e] + v1[e] * v1[e];
                    *(u32x4*)(MRG + (size_t)row * 1024 + 512 + col) = pack8(v0, v1); }
                ss += __shfl_xor(ss, 16); ss += __shfl_xor(ss, 32);
                if (fq == 0) atomicAdd(STAT + (size_t)row * 2 + 1, ss); }
    }
};
struct EpiOut {
    static constexpr bool MIDK = true;
    const float *xp, *xs, *MOD, *STAT; bf16_t* X1;
    __device__ __forceinline__ void mid(Acc& acc, const Unit& u, int wr, int fr) const {
        asm volatile("" : "+v"(fr));
#pragma unroll
        for (int ai = 0; ai < 2; ++ai)
#pragma unroll
            for (int m = 0; m < 4; ++m) { const int row = u.pm * 256 + ai * 128 + wr * 64 + m * 16 + fr;
                const f32x2 st = *(const f32x2*)(STAT + (size_t)row * 2);
                const float ratio = __builtin_amdgcn_rsqf(st[0] * (1.0f / 512.0f) + EPS) * __builtin_sqrtf(st[1] * (1.0f / 512.0f) + EPS);
#pragma unroll
                for (int bj = 0; bj < 2; ++bj) { acc[ai][bj][m][0] = acc[ai][bj][m][0] * ratio; acc[ai][bj][m][1] = acc[ai][bj][m][1] * ratio; } }
    }
    __device__ __forceinline__ void operator()(const Acc& acc, const Unit& u, int wr, int wc, int fr, int fq) const {
        asm volatile("" : "+v"(fr), "+v"(fq));
#pragma unroll
        for (int ai = 0; ai < 2; ++ai)
#pragma unroll
            for (int m = 0; m < 4; ++m) { const int row = u.pm * 256 + ai * 128 + wr * 64 + m * 16 + fr;
                const float* xr = row < MP ? xp + (size_t)row * D : xs + (size_t)(row - MP) * D; const float* gr = MOD + (size_t)mod_row(row) * NMOD + 2048;
                const float rb = __builtin_amdgcn_rsqf(STAT[(size_t)row * 2 + 1] * (1.0f / 512.0f) + EPS);
#pragma unroll
                for (int bj = 0; bj < 2; ++bj) { const int col = u.pn * 256 + bj * 128 + wc * 32 + 8 * fq;
                    const f32x4 x0 = *(const f32x4*)(xr + col), x1 = *(const f32x4*)(xr + col + 4), g0 = *(const f32x4*)(gr + col) * rb, g1 = *(const f32x4*)(gr + col + 4) * rb;
                    const u32x4 pk = pack8(x0 + g0 * acc[ai][bj][m][0], x1 + g1 * acc[ai][bj][m][1]);
                    if (u.pm >= MP / 256) wt16(X1, ((unsigned)row * D + col) * 2u, pk);
                    else *(u32x4*)(X1 + (size_t)row * D + col) = pk; } }
    }
};
struct EpiGU {
    static constexpr bool MIDK = false;
    bf16_t* HB;
    __device__ __forceinline__ void operator()(const Acc& acc, const Unit& u, int wr, int wc, int fr, int fq) const {
        asm volatile("" : "+v"(fr), "+v"(fq));
#pragma unroll
        for (int ai = 0; ai < 2; ++ai)
#pragma unroll
            for (int m = 0; m < 4; ++m) { const int row = u.pm * 256 + ai * 128 + wr * 64 + m * 16 + fr;
                f32x4 v0, v1;
#pragma unroll
                for (int e = 0; e < 4; ++e) { v0[e] = siluf_(acc[ai][0][m][0][e]) * acc[ai][1][m][0][e]; v1[e] = siluf_(acc[ai][0][m][1][e]) * acc[ai][1][m][1][e]; }
                *(u32x4*)(HB + (size_t)row * FF + u.pn * 128 + wc * 32 + 8 * fq) = pack8(v0, v1); }
    }
};
struct EpiDown {
    static constexpr bool MIDK = false;
    const bf16_t* X1; const float* MOD; float* out;
    __device__ __forceinline__ void operator()(const Acc& acc, const Unit& u, int wr, int wc, int fr, int fq) const {
        asm volatile("" : "+v"(fr), "+v"(fq));
#pragma unroll
        for (int ai = 0; ai < 2; ++ai)
#pragma unroll
            for (int m = 0; m < 4; ++m) { const int row = u.pm * 256 + ai * 128 + wr * 64 + m * 16 + fr;
                const bf16_t* xr = X1 + (size_t)row * D; const float* gr = MOD + (size_t)mod_row(row) * NMOD + 5120;
                float* orow = row < MP ? out + OFF_Y0 + (size_t)row * D : out + OFF_Y1 + (size_t)(row - MP) * D;
#pragma unroll
                for (int bj = 0; bj < 2; ++bj) { const int col = u.pn * 256 + bj * 128 + wc * 32 + 8 * fq;
                    const u32x4 xw = *(const u32x4*)(xr + col); const f32x4 x0 = {bflo(xw.x), bfhi(xw.x), bflo(xw.y), bfhi(xw.y)}, x1 = {bflo(xw.z), bfhi(xw.z), bflo(xw.w), bfhi(xw.w)};
                    const f32x4 g0 = *(const f32x4*)(gr + col), g1 = *(const f32x4*)(gr + col + 4);
                    *(f32x4*)(orow + col) = x0 + g0 * acc[ai][bj][m][0]; *(f32x4*)(orow + col + 4) = x1 + g1 * acc[ai][bj][m][1]; } }
    }
};

#define XB_TMO      128
#define XB_XCNT(j)  (256  + 64 * (j))
#define XB_XSUB(j)  (1280 + 64 * (j))
#define XB_XGEN(j)  (2304 + 64 * (j))
#define XB_TOP      3328
#define XB_TOPGEN   3392
#define XCD_BAR_WORDS 3456
#define XB_SPIN_CAP (1u << 18)
__device__ __forceinline__ unsigned xb_ld(unsigned* p)              { return __hip_atomic_load(p, __ATOMIC_RELAXED, __HIP_MEMORY_SCOPE_AGENT); }
__device__ __forceinline__ unsigned xb_add(unsigned* p, unsigned v) { return __hip_atomic_fetch_add(p, v, __ATOMIC_RELAXED, __HIP_MEMORY_SCOPE_AGENT); }
__device__ __forceinline__ unsigned xb_xcc_id() { return (unsigned)__builtin_amdgcn_s_getreg((3 << 11) | 20) & 0xFu; }
#define XB_SPIN(cond, bar) do { unsigned _sp = 0; while (cond) { __builtin_amdgcn_s_sleep(1); \
    if ((++_sp & 255u) == 0u) { if (xb_ld(&(bar)[XB_TMO])) break; if (_sp > XB_SPIN_CAP) { atomicAdd(&(bar)[XB_TMO], 1u); break; } } } } while (0)
struct XcdBarrier { unsigned* bar; unsigned x; volatile LAS unsigned* st; };
__device__ __forceinline__ XcdBarrier xcd_barrier_post(unsigned* bar, volatile LAS unsigned* st) {
    XcdBarrier b; b.bar = bar; b.x = xb_xcc_id(); b.st = st;
    if (threadIdx.x == 0) (void)xb_add(&bar[XB_XCNT(b.x)], 1u);
    return b;
}
__device__ __forceinline__ void xcd_barrier_complete(unsigned* bar, unsigned x, unsigned& nloc, unsigned& nx) {
    const unsigned G = gridDim.x * gridDim.y * gridDim.z;
    unsigned sum, cnt, mine, sp = 0u;
    for (;;) {
        sum = 0u; cnt = 0u; mine = 0u;
#pragma unroll
        for (unsigned j = 0; j < 16; ++j) { const unsigned c = xb_ld(&bar[XB_XCNT(j)]); sum += c; cnt += (c > 0u) ? 1u : 0u; mine = (j == x) ? c : mine; }
        if (sum == G) break;
        __builtin_amdgcn_s_sleep(1);
        if ((++sp & 255u) == 0u) { if (xb_ld(&bar[XB_TMO])) break; if (sp > XB_SPIN_CAP) { atomicAdd(&bar[XB_TMO], 1u); break; } }
    }
    nloc = mine > 0u ? mine : 1u; nx = cnt > 0u ? cnt : 1u;
}
__device__ __forceinline__ void xcd_barrier(const XcdBarrier& b) {
    asm volatile("s_waitcnt vmcnt(0)" ::: "memory");
    __syncthreads();
    if (threadIdx.x == 0) {
        unsigned* bar = b.bar;
        __builtin_amdgcn_s_waitcnt(0);
        unsigned nloc = b.st[0], nx = b.st[1];
        if (nloc == 0u) { xcd_barrier_complete(bar, b.x, nloc, nx); b.st[0] = nloc; b.st[1] = nx; }
        const unsigned old = xb_add(&bar[XB_XSUB(b.x)], 1u);
        const unsigned gen = old / nloc;
        if (old + 1u == (gen + 1u) * nloc) {
            __builtin_amdgcn_fence(__ATOMIC_RELEASE, "agent");
            asm volatile("s_waitcnt vmcnt(0)" ::: "memory");
            const unsigned og = xb_add(&bar[XB_TOP], 1u);
            const unsigned tg = og / nx;
            if (og + 1u == (tg + 1u) * nx) xb_add(&bar[XB_TOPGEN], 1u);
            else XB_SPIN(xb_ld(&bar[XB_TOPGEN]) == tg, bar);
            __builtin_amdgcn_fence(__ATOMIC_ACQUIRE, "agent");
            xb_add(&bar[XB_XGEN(b.x)], 1u);
            asm volatile("s_waitcnt vmcnt(0)" ::: "memory");
        } else {
            XB_SPIN(xb_ld(&bar[XB_XGEN(b.x)]) == gen, bar);
            __builtin_amdgcn_fence(__ATOMIC_ACQUIRE, "agent");
            asm volatile("s_waitcnt vmcnt(0)" ::: "memory");
        }
    }
    __syncthreads();
}

struct Args { const float* in[30]; float* out; unsigned char* ws; int ph_lo, ph_hi; };
struct Frame {
    LAS unsigned char* lds; int tid, lane, wave, vcu, G;
};
#define WSP(T, off) ((T*)(A.ws + (off)))

template <class RowMap>
__device__ __forceinline__ void p0_transpose_item(const float* W, int K, int N, bf16_t* WT, const RowMap& rm, LAS float* scr, int item, int lane, const float* kgain = nullptr) {
    const int nblk = N / 32, kb = item / nblk, nb = item % nblk, k0 = 64 * kb, n0 = 32 * nb;
    { const int kq = lane >> 3, nq = lane & 7; f32x4 v[8];
#pragma unroll
      for (int i = 0; i < 8; ++i) v[i] = *(const f32x4*)(W + (size_t)(k0 + 8 * i + kq) * N + n0 + 4 * nq);
#pragma unroll
      for (int i = 0; i < 8; ++i) { LAS float* d = scr + (8 * i + kq) * 33 + 4 * nq; d[0] = v[i][0]; d[1] = v[i][1]; d[2] = v[i][2]; d[3] = v[i][3]; } }
    asm volatile("s_waitcnt lgkmcnt(0)" ::: "memory");
    const int c = lane & 7;
    f32x4 ga = {1.f, 1.f, 1.f, 1.f}, gb = ga;
    if (kgain) { ga = *(const f32x4*)(kgain + k0 + 8 * c); gb = *(const f32x4*)(kgain + k0 + 8 * c + 4); }
#pragma unroll
    for (int j = 0; j < 4; ++j) { const int n = (lane >> 3) + 8 * j; const LAS float* s = scr + (8 * c) * 33 + n;
        u32x4 o; o.x = cvt_pk_bf16(s[0 * 33] * ga[0], s[1 * 33] * ga[1]); o.y = cvt_pk_bf16(s[2 * 33] * ga[2], s[3 * 33] * ga[3]); o.z = cvt_pk_bf16(s[4 * 33] * gb[0], s[5 * 33] * gb[1]); o.w = cvt_pk_bf16(s[6 * 33] * gb[2], s[7 * 33] * gb[3]);
        *(GAS u32x4*)(WT + (size_t)rm(n0 + n) * K + k0 + 8 * c) = o; }
    asm volatile("s_waitcnt lgkmcnt(0)" ::: "memory");
}
struct RmId { __device__ __forceinline__ int operator()(int n) const { return n; } };
struct RmIn { __device__ __forceinline__ int operator()(int F) const { const int f = F & 255; return (F & ~255) + 128 * ((f >> 5) & 1) + 32 * (f >> 6) + (f & 31); } };
struct RmGU { int up; __device__ __forceinline__ int operator()(int h) const { return 256 * (h >> 7) + 128 * up + (h & 127); } };

struct S5n { double dt, lr, li; float cr, ci; };
__device__ __forceinline__ S5n s5_setup(const Args& A, const Frame& F, int g, int n) {
    S5n s; s.dt = (double)expf(A.in[17][g]); s.lr = (double)A.in[15][g * 64 + n]; s.li = (double)A.in[16][g * 64 + n];
    double ar, ai; abar_pow(1.0, s.dt, s.lr, s.li, ar, ai);
    const double nr = ar - 1.0, ni = ai, den = s.lr * s.lr + s.li * s.li;
    s.cr = (float)((nr * s.lr + ni * s.li) / den); s.ci = (float)((ni * s.lr - nr * s.li) / den);
    return s;
}
__device__ __forceinline__ void p0_tmat_task(const Args& A, const Frame& F, int task, LAS float* scr) {
    const int g = task >> 4, c = task & 15, n = F.lane;
    const S5n s = s5_setup(A, F, g, n);
    const float Cr = A.in[20][(g * 16 + c) * 64 + n], Ci = A.in[21][(g * 16 + c) * 64 + n];
    float br[16], bi[16];
#pragma unroll
    for (int cp = 0; cp < 16; ++cp) { const float xr = A.in[18][(g * 64 + n) * 16 + cp], xi = A.in[19][(g * 64 + n) * 16 + cp]; br[cp] = s.cr * xr - s.ci * xi; bi[cp] = s.cr * xi + s.ci * xr; }
    const float dsk = A.in[22][g * 16 + c];
    bf16_t* T = WSP(bf16_t, WS_TMAT) + (size_t)g * 256 * KA;
    double a1r, a1i; abar_pow(1.0, s.dt, s.lr, s.li, a1r, a1i);
    double pr = 1.0, pi = 0.0;
#pragma unroll 1
    for (int j = 0; j < 16; ++j) {
        const float wr_ = (float)pr, wi_ = (float)pi, cwr = Cr * wr_ - Ci * wi_, cwi = Cr * wi_ + Ci * wr_;
#pragma unroll
        for (int cp = 0; cp < 16; ++cp) { float v = wave_sum(cwr * br[cp] - cwi * bi[cp]); if (j == 0 && cp == c) v += dsk; if (n == 0) scr[j * 16 + cp] = v; }
        const double qr = pr * a1r - pi * a1i, qi = pr * a1i + pi * a1r; pr = qr; pi = qi;
        const float q_r = (float)qr, q_i = (float)qi;
        bf16_t* row = T + (size_t)(j * 16 + c) * KA;
        row[256 + n] = (bf16_t)(cvt_pk_bf16(Cr * q_r - Ci * q_i, 0.f) & 0xffffu);
        row[320 + n] = (bf16_t)(cvt_pk_bf16(-(Cr * q_i + Ci * q_r), 0.f) & 0xffffu);
    }
    asm volatile("s_waitcnt lgkmcnt(0)" ::: "memory");
    for (int t = 0; t < 16; ++t) {
        const int sidx = n >> 2, c0 = (n & 3) * 4, j = t - sidx; float v[4];
#pragma unroll
        for (int e = 0; e < 4; ++e) v[e] = (j >= 0) ? scr[(j < 0 ? 0 : j) * 16 + c0 + e] : 0.f;
        u32x2 w; w.x = cvt_pk_bf16(v[0], v[1]); w.y = cvt_pk_bf16(v[2], v[3]);
        *(u32x2*)(T + (size_t)(t * 16 + c) * KA + 4 * n) = w;
    }
    asm volatile("s_waitcnt lgkmcnt(0)" ::: "memory");
}
__device__ __forceinline__ void p0_wend_task(const Args& A, const Frame& F, int task) {
    const int g = task >> 4, sidx = task & 15, n = F.lane;
    const S5n s = s5_setup(A, F, g, n);
    double pr, pi; abar_pow((double)(15 - sidx), s.dt, s.lr, s.li, pr, pi);
    const float wr_ = (float)pr, wi_ = (float)pi;
    float re[16], im[16];
#pragma unroll
    for (int cp = 0; cp < 16; ++cp) { const float xr = A.in[18][(g * 64 + n) * 16 + cp], xi = A.in[19][(g * 64 + n) * 16 + cp]; const float br = s.cr * xr - s.ci * xi, bi = s.cr * xi + s.ci * xr;
        re[cp] = wr_ * br - wi_ * bi; im[cp] = wr_ * bi + wi_ * br; }
    bf16_t* W = WSP(bf16_t, WS_WEND) + (size_t)g * 256 * 256;
    u32x4 a, b;
    a.x = cvt_pk_bf16(re[0], re[1]); a.y = cvt_pk_bf16(re[2], re[3]); a.z = cvt_pk_bf16(re[4], re[5]); a.w = cvt_pk_bf16(re[6], re[7]);
    b.x = cvt_pk_bf16(re[8], re[9]); b.y = cvt_pk_bf16(re[10], re[11]); b.z = cvt_pk_bf16(re[12], re[13]); b.w = cvt_pk_bf16(re[14], re[15]);
    *(u32x4*)(W + (size_t)n * 256 + sidx * 16) = a; *(u32x4*)(W + (size_t)n * 256 + sidx * 16 + 8) = b;
    a.x = cvt_pk_bf16(im[0], im[1]); a.y = cvt_pk_bf16(im[2], im[3]); a.z = cvt_pk_bf16(im[4], im[5]); a.w = cvt_pk_bf16(im[6], im[7]);
    b.x = cvt_pk_bf16(im[8], im[9]); b.y = cvt_pk_bf16(im[10], im[11]); b.z = cvt_pk_bf16(im[12], im[13]); b.w = cvt_pk_bf16(im[14], im[15]);
    *(u32x4*)(W + (size_t)(64 + n) * 256 + sidx * 16) = a; *(u32x4*)(W + (size_t)(64 + n) * 256 + sidx * 16 + 8) = b;
}
__device__ __forceinline__ void p0_prologue(const Args& A, Frame& F) {
    LAS float* scr = (LAS float*)(F.lds + F.wave * 16384);
    for (int i = F.vcu * (NWAVES * 64) + F.tid; i < M * 2 / 4; i += F.G * NWAVES * 64) *(f32x4*)(WSP(float, WS_STAT) + 4 * (size_t)i) = (f32x4){0.f, 0.f, 0.f, 0.f};
    const int gw = F.vcu * NWAVES + F.wave, NGW = F.G * NWAVES;
    constexpr int I_ADA = 16 * 192, I_CS = 256;
    for (int it = gw; it < I_CS + I_ADA; it += NGW) {
        int r = it;
        if (r < I_CS) {
            const float* cr = r < 2 ? A.in[6] + (size_t)r * D : (r < NMODROWS ? A.in[7] + (size_t)(r - 2) * D : nullptr);
            bf16_t* o = WSP(bf16_t, WS_CS) + (size_t)r * D;
#pragma unroll
            for (int j = 0; j < 4; ++j) { f32x4 v = {0.f, 0.f, 0.f, 0.f}; if (cr) { v = *(const f32x4*)(cr + 4 * (F.lane + 64 * j)); v[0] = siluf_(v[0]); v[1] = siluf_(v[1]); v[2] = siluf_(v[2]); v[3] = siluf_(v[3]); }
                u32x2 w; w.x = cvt_pk_bf16(v[0], v[1]); w.y = cvt_pk_bf16(v[2], v[3]); *(u32x2*)(o + 4 * (F.lane + 64 * j)) = w; }
            continue; } r -= I_CS;
        p0_transpose_item(A.in[10], D, NMOD, WSP(bf16_t, WS_WADA), RmId{}, scr, r, F.lane);
    }
}
__device__ __forceinline__ void p1_side_work(const Args& A, Frame& F, int rank, int nranks) {
    LAS float* scr = (LAS float*)(F.lds + F.wave * 16384);
    const int gw = rank * NWAVES + F.wave, NGW = nranks * NWAVES;
    constexpr int I_IN = 16 * 64, I_GLU = 8 * 16, I_OUT = 16 * 32, I_G = 16 * 88, I_DN = 44 * 32, I_TM = 512, I_WE = 512;
    constexpr int NITEMS = I_IN + I_GLU + I_OUT + 2 * I_G + I_DN + I_TM + I_WE;
    for (int it = gw; it < NITEMS; it += NGW) {
        int r = it;
        if (r < I_TM) { p0_tmat_task(A, F, r, scr); continue; } r -= I_TM;
        if (r < I_WE) { p0_wend_task(A, F, r); continue; } r -= I_WE;
        if (r < I_IN) { p0_transpose_item(A.in[12], D, NIN, WSP(bf16_t, WS_WIN), RmIn{}, scr, r, F.lane); continue; } r -= I_IN;
        if (r < I_GLU) { p0_transpose_item(A.in[23], 512, 512, WSP(bf16_t, WS_WGLU), RmId{}, scr, r, F.lane); continue; } r -= I_GLU;
        if (r < I_OUT) { const int kb = r / 32;
            p0_transpose_item(A.in[26], D, D, WSP(bf16_t, WS_WOUT), RmId{}, scr, r, F.lane, kb < 8 ? A.in[24] : A.in[25] - 512); continue; } r -= I_OUT;
        if (r < I_G) { p0_transpose_item(A.in[27], D, FF, WSP(bf16_t, WS_WGU), RmGU{0}, scr, r, F.lane); continue; } r -= I_G;
        if (r < I_G) { p0_transpose_item(A.in[28], D, FF, WSP(bf16_t, WS_WGU), RmGU{1}, scr, r, F.lane); continue; } r -= I_G;
        p0_transpose_item(A.in[29], FF, D, WSP(bf16_t, WS_WDN), RmId{}, scr, r, F.lane);
    }
    { const int gt = rank * (NWAVES * 64) + F.tid, NT = nranks * NWAVES * 64;
      for (int i = gt; i < 32 * 128 * 32; i += NT) { const int g = i >> 12, rem = i & 4095; *(u32x4*)(WSP(bf16_t, WS_WEND) + (size_t)g * 65536 + 128 * 256 + (size_t)rem * 8) = (u32x4){0u, 0u, 0u, 0u}; } }
}

constexpr int CP_NRUN = 2 * 128 * 96, CP_PART = 32, CP_NPART = CP_NRUN / CP_PART;
__device__ __forceinline__ void copy_half_run(const Args& A, int R, int half, int lane) {
    const int tz = R >= 12288 ? 1 : 0, r = R - 12288 * tz, b = r / 96, run = r - 96 * b;
    const size_t off = ((size_t)b * 2048 + 16 * run) * 2048 + (size_t)half * 12288;
    const char* src = (const char*)(tz ? A.in[3] : A.in[2]) + off + 4 * 2048 + lane * 16; char* dst = (char*)(A.out + (tz ? OFF_VS : OFF_KS)) + off + lane * 16;
    u32x4 v[12];
#pragma unroll
    for (int j = 0; j < 12; ++j) v[j] = __builtin_nontemporal_load((const u32x4*)(src + j * 1024));
#pragma unroll
    for (int j = 0; j < 12; ++j) __builtin_nontemporal_store(v[j], (u32x4*)(dst + j * 1024));
}
__device__ __forceinline__ void stream_copy(const Args& A, Frame& F, unsigned* done, unsigned target) {
    LAS int* L = (LAS int*)(F.lds + LDSCTL_OFF);
    unsigned* gctr = (unsigned*)(A.ws + WS_CTL) + CW_CPCTR;
    if (F.tid == 0) L[9] = 0;
    __syncthreads();
    for (;;) {
        if (L[10]) break;
        if (L[0] == 0) {
            __syncthreads();
            if (F.tid == 0) { const unsigned p = __hip_atomic_fetch_add(gctr, 1u, __ATOMIC_RELAXED, __HIP_MEMORY_SCOPE_AGENT); if (p < (unsigned)CP_NPART) L[0] = (int)p + 1; else L[10] = 1; }
            if (F.tid < 8) L[1 + F.tid] = 0;
            __syncthreads();
            if (L[10]) break;
        }
        const int part = __builtin_amdgcn_readfirstlane(L[0]) - 1;
        int c = __builtin_amdgcn_readfirstlane(L[1 + F.wave]);
        while (c < 8) {
            if (done) {
                if (F.wave == 0 && F.lane == 0 && __hip_atomic_load(done + 64 * (F.vcu & 7), __ATOMIC_RELAXED, __HIP_MEMORY_SCOPE_AGENT) >= target) L[9] = 1;
                if (__builtin_amdgcn_readfirstlane(L[9])) break;
            }
            copy_half_run(A, part * CP_PART + F.wave + 8 * (c >> 1), c & 1, F.lane); ++c;
        }
        if (F.lane == 0) L[1 + F.wave] = c;
        if (done && F.wave == 0) {
            for (;;) { bool all = true;
#pragma unroll
                for (int w = 1; w < 8; ++w) all = all && (__builtin_amdgcn_readfirstlane(L[1 + w]) == 8);
                if (all || __builtin_amdgcn_readfirstlane(L[9])) break;
                if (F.lane == 0 && __hip_atomic_load(done + 64 * (F.vcu & 7), __ATOMIC_RELAXED, __HIP_MEMORY_SCOPE_AGENT) >= target) L[9] = 1;
                __builtin_amdgcn_s_sleep(8); }
        }
        __syncthreads();
        if (L[9]) break;
        if (F.tid == 0) L[0] = 0;
        __syncthreads();
    }
    __syncthreads();
}
__device__ __forceinline__ void signal_done(const Args& A, Frame& F, int k) {
    asm volatile("s_waitcnt vmcnt(0)" ::: "memory"); __syncthreads();
    if (F.tid < 8) __hip_atomic_fetch_add((unsigned*)(A.ws + WS_CTL) + CW_DONE + 512 * k + 64 * F.tid, 1u, __ATOMIC_RELAXED, __HIP_MEMORY_SCOPE_AGENT);
}
#define DONE_WORD(k) ((unsigned*)(A.ws + WS_CTL) + CW_DONE + 512 * (k))

__device__ __forceinline__ void wait_done(const Args& A, Frame& F, int k, unsigned target) {
    __syncthreads();
    if (F.tid == 0) { unsigned sp = 0; unsigned* dw = DONE_WORD(k) + 64 * (F.vcu & 7); unsigned* tmo = (unsigned*)(A.ws + WS_CTL) + CW_BAR + XB_TMO;
        while (__hip_atomic_load(dw, __ATOMIC_RELAXED, __HIP_MEMORY_SCOPE_AGENT) < target) { __builtin_amdgcn_s_sleep(2);
            if ((++sp & 255u) == 0u) { if (xb_ld(tmo)) break; if (sp > XB_SPIN_CAP) { atomicAdd(tmo, 1u); break; } } } }
    __syncthreads();
    __builtin_amdgcn_fence(__ATOMIC_ACQUIRE, "agent"); asm volatile("s_waitcnt vmcnt(0)" ::: "memory");
}
template <bool XBF, class XT>
__device__ __forceinline__ void norm_mod_pass(const Args& A, Frame& F, const XT* xp, const XT* xs, const float* gain, int sh_off, int sc_off, bf16_t* XN, int row0, int row1, int gw, int NGW, const bool wthru = false) {
    const float* MOD = WSP(float, WS_MOD);
    for (int row = row0 + gw; row < row1; row += NGW) {
        const XT* xr = row < MP ? xp + (size_t)row * D : xs + (size_t)(row - MP) * D; const float* mr = MOD + (size_t)mod_row(row) * NMOD;
        f32x4 v[4]; float s = 0.f;
#pragma unroll
        for (int j = 0; j < 4; ++j) {
            if constexpr (XBF) { const u32x2 xw = *(const u32x2*)(xr + 4 * (F.lane + 64 * j)); v[j] = (f32x4){bflo(xw.x), bfhi(xw.x), bflo(xw.y), bfhi(xw.y)}; }
            else v[j] = *(const f32x4*)(xr + 4 * (F.lane + 64 * j));
            s += (v[j][0] * v[j][0] + v[j][1] * v[j][1]) + (v[j][2] * v[j][2] + v[j][3] * v[j][3]); }
        const float rs = __builtin_amdgcn_rsqf(wave_sum(s) * (1.0f / D) + EPS);
#pragma unroll
        for (int j = 0; j < 4; ++j) { const int col = 4 * (F.lane + 64 * j);
            const f32x4 g = *(const f32x4*)(gain + col), sc = *(const f32x4*)(mr + sc_off + col), sh = *(const f32x4*)(mr + sh_off + col);
            const f32x4 h = v[j] * rs * g * (sc + 1.0f) + sh;
            u32x2 w; w.x = cvt_pk_bf16(h[0], h[1]); w.y = cvt_pk_bf16(h[2], h[3]);
            if (wthru) __builtin_amdgcn_raw_buffer_store_b64(w, __builtin_amdgcn_make_buffer_rsrc((void*)XN, 0, 0xffffffffu, 0x00020000), (int)(((unsigned)row * D + col) * 2u), 0, 16);
            else *(u32x2*)(XN + (size_t)row * D + col) = w; }
    }
}
__device__ __forceinline__ void merged_norm_pass(const Args& A, Frame& F) {
    const int gw = F.vcu * NWAVES + F.wave, NGW = F.G * NWAVES; const bf16_t* MRG = WSP(bf16_t, WS_MRG); bf16_t* O = WSP(bf16_t, WS_XN);
    for (int row = gw; row < M; row += NGW) {
        const u32x4 a = *(const u32x4*)(MRG + (size_t)row * D + 8 * F.lane), b = *(const u32x4*)(MRG + (size_t)row * D + 512 + 8 * F.lane);
        float av[8] = {bflo(a.x), bfhi(a.x), bflo(a.y), bfhi(a.y), bflo(a.z), bfhi(a.z), bflo(a.w), bfhi(a.w)};
        float bv[8] = {bflo(b.x), bfhi(b.x), bflo(b.y), bfhi(b.y), bflo(b.z), bfhi(b.z), bflo(b.w), bfhi(b.w)};
        float sa = 0.f, sb = 0.f;
#pragma unroll
        for (int e = 0; e < 8; ++e) { sa += av[e] * av[e]; sb += bv[e] * bv[e]; }
        const float ra = __builtin_amdgcn_rsqf(wave_sum(sa) * (1.0f / 512.0f) + EPS), rb = __builtin_amdgcn_rsqf(wave_sum(sb) * (1.0f / 512.0f) + EPS);
        const float* ga = A.in[24] + 8 * F.lane; const float* gs = A.in[25] + 8 * F.lane;
        const f32x4 ga0 = *(const f32x4*)ga, ga1 = *(const f32x4*)(ga + 4), gs0 = *(const f32x4*)gs, gs1 = *(const f32x4*)(gs + 4);
        u32x4 oa, ob;
        oa.x = cvt_pk_bf16(av[0] * ra * ga0[0], av[1] * ra * ga0[1]); oa.y = cvt_pk_bf16(av[2] * ra * ga0[2], av[3] * ra * ga0[3]);
        oa.z = cvt_pk_bf16(av[4] * ra * ga1[0], av[5] * ra * ga1[1]); oa.w = cvt_pk_bf16(av[6] * ra * ga1[2], av[7] * ra * ga1[3]);
        ob.x = cvt_pk_bf16(bv[0] * rb * gs0[0], bv[1] * rb * gs0[1]); ob.y = cvt_pk_bf16(bv[2] * rb * gs0[2], bv[3] * rb * gs0[3]);
        ob.z = cvt_pk_bf16(bv[4] * rb * gs1[0], bv[5] * rb * gs1[1]); ob.w = cvt_pk_bf16(bv[6] * rb * gs1[2], bv[7] * rb * gs1[3]);
        *(u32x4*)(O + (size_t)row * D + 8 * F.lane) = oa; *(u32x4*)(O + (size_t)row * D + 512 + 8 * F.lane) = ob;
    }
}

constexpr float NEGBIG = -1.0e30f;
constexpr int VROWB = 144;
constexpr int AT_ACC_OFF = 40960, AT_PITCH = 68, AT_L_OFF = AT_ACC_OFF + 256 * AT_PITCH * 4;
__device__ __forceinline__ s16x4 vtr(const LAS unsigned char* p) { typedef short v4i16_t __attribute__((ext_vector_type(4))); return __builtin_bit_cast(s16x4, __builtin_amdgcn_ds_read_tr16_b64_v4i16((LAS v4i16_t*)p)); }
struct AttnAcc { f32x4 O[4]; float l; };
__device__ __forceinline__ void attn_load_q(const bf16_t* Qb, size_t rowb, int h, int tq, float kmax, bf16x8 (&qf)[2], float& cshift, int lane) {
    const int g = lane >> 4;
    const bf16_t* qp = Qb + (rowb + tq) * 512 + h * 64 + 8 * g; qf[0] = *(const bf16x8*)qp; qf[1] = *(const bf16x8*)(qp + 32);
    float ss = 0.f;
#pragma unroll
    for (int e = 0; e < 8; ++e) { const float x = bf2f((unsigned short)qf[0][e]), y = bf2f((unsigned short)qf[1][e]); ss += x * x + y * y; }
    ss += __shfl_xor(ss, 16); ss += __shfl_xor(ss, 32);
    cshift = __builtin_sqrtf(ss) * kmax;
}
__device__ __forceinline__ void attn_blocks(const bf16_t* Kb, const bf16_t* Vb, size_t rowb, int h, const bf16x8 (&qf)[2], float cshift, AttnAcc& acc, int T0, int dil, int sq, int nblk, LAS unsigned char* vlds, int lane) {
    const int iq = lane & 15, g = lane >> 4, vrow = lane >> 3, vch = lane & 7;
    const LAS unsigned char* vrd = vlds + (4 * g + (iq >> 2)) * VROWB + (iq & 3) * 8;
    const int jjmin = -(T0 / dil);
    int ddmax = sq * iq - jjmin; ddmax = ddmax > 128 ? 128 : ddmax;
    const f32x4 cinit = {-cshift, -cshift, -cshift, -cshift};
#pragma unroll 1
    for (int kb = 0; kb < nblk; ++kb) {
        const int jj0 = -128 + 32 * kb;
        if (T0 + dil * (jj0 + 31) < 0) continue;
        bf16x8 kf[2][2];
#pragma unroll
        for (int tl = 0; tl < 2; ++tl) { int tok = T0 + dil * (jj0 + 16 * tl + iq); tok = tok < 0 ? 0 : (tok > SEQ - 1 ? SEQ - 1 : tok);
            const bf16_t* kp = Kb + (rowb + tok) * 512 + h * 64 + 8 * g; kf[tl][0] = *(const bf16x8*)kp; kf[tl][1] = *(const bf16x8*)(kp + 32); }
        u32x4 vreg[4];
#pragma unroll
        for (int rep = 0; rep < 4; ++rep) { int tok = T0 + dil * (jj0 + vrow + 8 * rep); tok = tok < 0 ? 0 : (tok > SEQ - 1 ? SEQ - 1 : tok);
            vreg[rep] = *(const u32x4*)(Vb + (rowb + tok) * 512 + h * 64 + 8 * vch); }
        f32x4 st[2];
#pragma unroll
        for (int tl = 0; tl < 2; ++tl) { st[tl] = __builtin_amdgcn_mfma_f32_16x16x32_bf16(kf[tl][0], qf[0], cinit, 0, 0, 0);
            st[tl] = __builtin_amdgcn_mfma_f32_16x16x32_bf16(kf[tl][1], qf[1], st[tl], 0, 0, 0); }
#pragma unroll
        for (int rep = 0; rep < 4; ++rep) *(LAS u32x4*)(vlds + (vrow + 8 * rep) * VROWB + vch * 16) = vreg[rep];
        const int base = sq * iq - 4 * g - jj0; float p[8]; float ps = 0.f;
#pragma unroll
        for (int j = 0; j < 8; ++j) { const int dd = base - (16 * (j >> 2) + (j & 3)); p[j] = ((unsigned)dd <= (unsigned)ddmax) ? fexp2(st[j >> 2][j & 3]) : 0.f; ps += p[j]; }
        acc.l += ps;
        bf16x8 pf; { u32x4 w; w.x = cvt_pk_bf16(p[0], p[1]); w.y = cvt_pk_bf16(p[2], p[3]); w.z = cvt_pk_bf16(p[4], p[5]); w.w = cvt_pk_bf16(p[6], p[7]); pf = __builtin_bit_cast(bf16x8, w); }
        asm volatile("s_waitcnt lgkmcnt(0)" ::: "memory");
#pragma unroll
        for (int d = 0; d < 4; ++d) {
            const s16x4 lo = vtr(vrd + d * 32), hi = vtr(vrd + d * 32 + 16 * VROWB);
            const bf16x8 vf = (bf16x8){lo[0], lo[1], lo[2], lo[3], hi[0], hi[1], hi[2], hi[3]};
            acc.O[d] = __builtin_amdgcn_mfma_f32_16x16x32_bf16(vf, pf, acc.O[d], 0, 0, 0);
        }
        asm volatile("s_waitcnt lgkmcnt(0)" ::: "memory");
    }
}
template <int DIL, int SQ, int NBLK, int OFFB>
__device__ __forceinline__ void attn_blocks2(const bf16_t* Kb, const bf16_t* Vb, size_t rowb, int h, const bf16x8 (&qfA)[2], float csA, AttnAcc& accA, const bf16x8 (&qfB)[2], float csB, AttnAcc& accB,
                                             int T0, LAS unsigned char* vlds, int lane) {
    const int iq = lane & 15, g = lane >> 4, vrow = lane >> 3, vch = lane & 7;
    const LAS unsigned char* vrd = vlds + (4 * g + (iq >> 2)) * VROWB + (iq & 3) * 8;
    const int jjmin = -(T0 / DIL);
    int ddmaxA = SQ * iq - jjmin; ddmaxA = ddmaxA > 128 ? 128 : ddmaxA;
    int ddmaxB = SQ * iq + OFFB - jjmin; ddmaxB = ddmaxB > 128 ? 128 : ddmaxB;
    const f32x4 cinitA = {-csA, -csA, -csA, -csA}, cinitB = {-csB, -csB, -csB, -csB};
#pragma unroll 1
    for (int kb = 0; kb < NBLK; ++kb) {
        const int jj0 = -128 + 32 * kb;
        if (T0 + DIL * (jj0 + 31) < 0) continue;
        bf16x8 kf[2][2];
#pragma unroll
        for (int tl = 0; tl < 2; ++tl) { int tok = T0 + DIL * (jj0 + 16 * tl + iq); tok = tok < 0 ? 0 : (tok > SEQ - 1 ? SEQ - 1 : tok);
            const bf16_t* kp = Kb + (rowb + tok) * 512 + h * 64 + 8 * g; kf[tl][0] = *(const bf16x8*)kp; kf[tl][1] = *(const bf16x8*)(kp + 32); }
        u32x4 vreg[4];
#pragma unroll
        for (int rep = 0; rep < 4; ++rep) { int tok = T0 + DIL * (jj0 + vrow + 8 * rep); tok = tok < 0 ? 0 : (tok > SEQ - 1 ? SEQ - 1 : tok);
            vreg[rep] = *(const u32x4*)(Vb + (rowb + tok) * 512 + h * 64 + 8 * vch); }
        f32x4 stA[2], stB[2];
#pragma unroll
        for (int tl = 0; tl < 2; ++tl) {
            stA[tl] = __builtin_amdgcn_mfma_f32_16x16x32_bf16(kf[tl][0], qfA[0], cinitA, 0, 0, 0); stA[tl] = __builtin_amdgcn_mfma_f32_16x16x32_bf16(kf[tl][1], qfA[1], stA[tl], 0, 0, 0);
            stB[tl] = __builtin_amdgcn_mfma_f32_16x16x32_bf16(kf[tl][0], qfB[0], cinitB, 0, 0, 0); stB[tl] = __builtin_amdgcn_mfma_f32_16x16x32_bf16(kf[tl][1], qfB[1], stB[tl], 0, 0, 0); }
#pragma unroll
        for (int rep = 0; rep < 4; ++rep) *(LAS u32x4*)(vlds + (vrow + 8 * rep) * VROWB + vch * 16) = vreg[rep];
        const int base = SQ * iq - 4 * g - jj0; float pA[8], pB[8]; float psA = 0.f, psB = 0.f;
#pragma unroll
        for (int j = 0; j < 8; ++j) { const int dd = base - (16 * (j >> 2) + (j & 3));
            pA[j] = ((unsigned)dd <= (unsigned)ddmaxA) ? fexp2(stA[j >> 2][j & 3]) : 0.f; psA += pA[j];
            pB[j] = ((unsigned)(dd + OFFB) <= (unsigned)ddmaxB) ? fexp2(stB[j >> 2][j & 3]) : 0.f; psB += pB[j]; }
        accA.l += psA; accB.l += psB;
        bf16x8 pfA, pfB;
        { u32x4 w; w.x = cvt_pk_bf16(pA[0], pA[1]); w.y = cvt_pk_bf16(pA[2], pA[3]); w.z = cvt_pk_bf16(pA[4], pA[5]); w.w = cvt_pk_bf16(pA[6], pA[7]); pfA = __builtin_bit_cast(bf16x8, w); }
        { u32x4 w; w.x = cvt_pk_bf16(pB[0], pB[1]); w.y = cvt_pk_bf16(pB[2], pB[3]); w.z = cvt_pk_bf16(pB[4], pB[5]); w.w = cvt_pk_bf16(pB[6], pB[7]); pfB = __builtin_bit_cast(bf16x8, w); }
        asm volatile("s_waitcnt lgkmcnt(0)" ::: "memory");
#pragma unroll
        for (int d = 0; d < 4; ++d) {
            const s16x4 lo = vtr(vrd + d * 32), hi = vtr(vrd + d * 32 + 16 * VROWB);
            const bf16x8 vf = (bf16x8){lo[0], lo[1], lo[2], lo[3], hi[0], hi[1], hi[2], hi[3]};
            accA.O[d] = __builtin_amdgcn_mfma_f32_16x16x32_bf16(vf, pfA, accA.O[d], 0, 0, 0);
            accB.O[d] = __builtin_amdgcn_mfma_f32_16x16x32_bf16(vf, pfB, accB.O[d], 0, 0, 0);
        }
        asm volatile("s_waitcnt lgkmcnt(0)" ::: "memory");
    }
}
__device__ __forceinline__ void prompt_attention(const Args& A, Frame& F, const int u0, const int du, const int nu, const int uextra) {
    const bf16_t* Qb = WSP(bf16_t, WS_Q); const bf16_t* Kb = WSP(bf16_t, WS_K); const bf16_t* Vb = WSP(bf16_t, WS_V); bf16_t* MRG = WSP(bf16_t, WS_MRG); float* STAT = WSP(float, WS_STAT);
    LAS unsigned char* vlds = F.lds + F.wave * 4608;
    LAS float* accl = (LAS float*)(F.lds + AT_ACC_OFF); LAS float* lacc = (LAS float*)(F.lds + AT_L_OFF);
    const int lane = F.lane, iq = lane & 15, g = lane >> 4;
    float kmax; { float x = fabsf(A.in[14][lane]);
#pragma unroll
        for (int o = 1; o < 64; o <<= 1) x = fmaxf(x, __shfl_xor(x, o));
        kmax = x * 8.0f * 1.01f; }
    for (int ku = 0; ku < nu + (uextra >= 0 ? 1 : 0); ++ku) {
        const int uu = ku < nu ? u0 + du * ku : uextra;
        const int blk = uu & 31, h = (uu >> 5) & 7, b = uu >> 8, Tb = blk * 256; const size_t rowb = (size_t)b * SEQ;
        { const int a = 2 * F.wave, TA = Tb + 16 * a;
            bf16x8 qfA[2], qfB[2]; float csA, csB; attn_load_q(Qb, rowb, h, TA + iq, kmax, qfA, csA, lane); attn_load_q(Qb, rowb, h, TA + 16 + iq, kmax, qfB, csB, lane);
            AttnAcc accA, accB; accA.l = 0.f; accB.l = 0.f;
#pragma unroll
            for (int d = 0; d < 4; ++d) { accA.O[d] = (f32x4){0.f, 0.f, 0.f, 0.f}; accB.O[d] = (f32x4){0.f, 0.f, 0.f, 0.f}; }
            attn_blocks2<1, 1, 6, 16>(Kb, Vb, rowb, h, qfA, csA, accA, qfB, csB, accB, TA, vlds, lane);
            float lA = accA.l, lB = accB.l; lA += __shfl_xor(lA, 16); lA += __shfl_xor(lA, 32); lB += __shfl_xor(lB, 16); lB += __shfl_xor(lB, 32);
            LAS float* ap = accl + (16 * a + iq) * AT_PITCH + 4 * g;
#pragma unroll
            for (int d = 0; d < 4; ++d) { *(LAS f32x4*)(ap + 16 * d) = accA.O[d]; *(LAS f32x4*)(ap + 16 * AT_PITCH + 16 * d) = accB.O[d]; }
            if (g == 0) { lacc[16 * a + iq] = lA; lacc[16 * a + 16 + iq] = lB; }
        }
        __syncthreads();
        { const int r = F.wave;
            bf16x8 qfA[2], qfB[2]; float csA, csB; attn_load_q(Qb, rowb, h, Tb + r + 16 * iq, kmax, qfA, csA, lane); attn_load_q(Qb, rowb, h, Tb + r + 8 + 16 * iq, kmax, qfB, csB, lane);
            AttnAcc accA, accB; accA.l = 0.f; accB.l = 0.f;
#pragma unroll
            for (int d = 0; d < 4; ++d) { accA.O[d] = (f32x4){0.f, 0.f, 0.f, 0.f}; accB.O[d] = (f32x4){0.f, 0.f, 0.f, 0.f}; }
            attn_blocks2<4, 4, 6, 2>(Kb, Vb, rowb, h, qfA, csA, accA, qfB, csB, accB, Tb + r, vlds, lane);
            attn_blocks(Kb, Vb, rowb, h, qfA, csA, accA, Tb + r, 16, 1, 5, vlds, lane);
            attn_blocks(Kb, Vb, rowb, h, qfB, csB, accB, Tb + r + 8, 16, 1, 5, vlds, lane);
            float lA = accA.l, lB = accB.l; lA += __shfl_xor(lA, 16); lA += __shfl_xor(lA, 32); lB += __shfl_xor(lB, 16); lB += __shfl_xor(lB, 32);
            LAS float* ap = accl + (r + 16 * iq) * AT_PITCH + 4 * g;
#pragma unroll
            for (int d = 0; d < 4; ++d) { const f32x4 o = *(LAS f32x4*)(ap + 16 * d); *(LAS f32x4*)(ap + 16 * d) = o + accA.O[d];
                const f32x4 o2 = *(LAS f32x4*)(ap + 8 * AT_PITCH + 16 * d); *(LAS f32x4*)(ap + 8 * AT_PITCH + 16 * d) = o2 + accB.O[d]; }
            if (g == 0) { lacc[r + 16 * iq] += lA; lacc[r + 8 + 16 * iq] += lB; }
        }
        __syncthreads();
        { const int q = F.tid >> 1, half = F.tid & 1; const float inv = 1.0f / lacc[q]; const LAS float* ap = accl + q * AT_PITCH + 32 * half;
          bf16_t* op = MRG + (rowb + Tb + q) * 1024 + h * 64 + 32 * half; float ss = 0.f;
#pragma unroll
          for (int kk = 0; kk < 4; ++kk) { const f32x4 x = *(const LAS f32x4*)(ap + 8 * kk) * inv, y = *(const LAS f32x4*)(ap + 8 * kk + 4) * inv; *(u32x4*)(op + 8 * kk) = pack8(x, y);
#pragma unroll
              for (int e = 0; e < 4; ++e) ss += x[e] * x[e] + y[e] * y[e]; }
          ss += dpp_mov<0xB1>(ss);
          if (half == 0) atomicAdd(STAT + (rowb + Tb + q) * 2, ss); }
        __syncthreads();
    }
}

struct SAState { float m[4], l[4]; f32x4 o[4]; };
__device__ __forceinline__ float red16(float v) { return row16_sum(v); }
__device__ __forceinline__ void sa_accum(SAState& S, int t, float s, float mult, const f32x4& v) {
    const float mnew = fmaxf(S.m[t], s), alpha = fexp2(S.m[t] - mnew), pw = mult * fexp2(s - mnew);
    S.l[t] = S.l[t] * alpha + pw; S.o[t] = S.o[t] * alpha + v * pw; S.m[t] = mnew;
}
__device__ __forceinline__ void sample_attention(const Args& A, Frame& F, const int maxu) {
    const float* QS = WSP(float, WS_QS); bf16_t* MRG = WSP(bf16_t, WS_MRG);
    LAS float* mg = (LAS float*)F.lds;
    LAS int* QL = (LAS int*)(F.lds + LDSCTL_OFF);
    for (int nu_ = 0; nu_ < maxu; ++nu_) {
        if (F.tid == 0) QL[16] = (int)__hip_atomic_fetch_add((unsigned*)(A.ws + WS_CTL) + CW_QS, 1u, __ATOMIC_RELAXED, __HIP_MEMORY_SCOPE_AGENT);
        __syncthreads();
        const int uu = __builtin_amdgcn_readfirstlane(QL[16]);
        if (uu >= 256) break;
        const int bs = uu >> 1, hh = uu & 1, hl = F.lane >> 4, head = 4 * hh + hl, dq = 4 * (F.lane & 15);
        const int coff = head * 64 + dq;
        f32x4 q[4];
#pragma unroll
        for (int t = 0; t < 4; ++t) q[t] = *(const f32x4*)(QS + (size_t)(bs * 4 + t) * 512 + coff);
        SAState S;
#pragma unroll
        for (int t = 0; t < 4; ++t) { S.m[t] = NEGBIG; S.l[t] = 0.f; S.o[t] = (f32x4){0.f, 0.f, 0.f, 0.f}; }
        const float* ck = A.in[2] + (size_t)bs * KVB * 512 + coff; const float* cv = A.in[3] + (size_t)bs * KVB * 512 + coff;
        const float* nk = A.out + OFF_KS + ((size_t)bs * KVB + (KVB - 4)) * 512 + coff; const float* nv = A.out + OFF_VS + ((size_t)bs * KVB + (KVB - 4)) * 512 + coff;
        float* dk = A.out + OFF_KS + (size_t)bs * KVB * 512 + coff; float* dv = A.out + OFF_VS + (size_t)bs * KVB * 512 + coff;
        f32x4 ka[8], va[8], kb[8], vb[8];
#define SA_LOAD_A(i0_, KK, VV) do { _Pragma("unroll") for (int j = 0; j < 8; ++j) { int p = 1536 + F.wave + 8 * ((i0_) + j); if (p > 2051) p = 2051; \
                KK[j] = p < KVB ? *(const f32x4*)(ck + (size_t)p * 512) : *(const f32x4*)(nk + (size_t)(p - KVB) * 512); \
                VV[j] = p < KVB ? *(const f32x4*)(cv + (size_t)p * 512) : *(const f32x4*)(nv + (size_t)(p - KVB) * 512); } } while (0)
#define SA_PROC_A(i0_, KK, VV) do { \
            _Pragma("unroll") for (int j = 0; j < 8; ++j) { const int p = 1536 + F.wave + 8 * ((i0_) + j); if (p < KVB) { __builtin_nontemporal_store(KK[j], (f32x4*)(dk + (size_t)(p - 4) * 512)); __builtin_nontemporal_store(VV[j], (f32x4*)(dv + (size_t)(p - 4) * 512)); } } \
            _Pragma("unroll") for (int j = 0; j < 8; ++j) { const int p = 1536 + F.wave + 8 * ((i0_) + j); if (p <= 2051) { \
                _Pragma("unroll") for (int t = 0; t < 4; ++t) { const int dist = KVB + t - p; \
                    if (dist >= 0) { const int mult = (dist <= 128 ? 1 : 0) + (((dist & 3) == 0 && dist <= 512) ? 1 : 0) + ((dist & 15) == 0 ? 1 : 0); \
                        if (mult > 0) { const float s = red16(q[t][0] * KK[j][0] + q[t][1] * KK[j][1] + q[t][2] * KK[j][2] + q[t][3] * KK[j][3]); sa_accum(S, t, s, (float)mult, VV[j]); } } } } } } while (0)
        SA_LOAD_A(0, ka, va);
#pragma unroll 1
        for (int i0 = 0; i0 < 72; i0 += 16) {
            if (i0 + 8 < 72) SA_LOAD_A(i0 + 8, kb, vb);
            SA_PROC_A(i0, ka, va);
            if (i0 + 16 < 72) SA_LOAD_A(i0 + 16, ka, va);
            if (i0 + 8 < 72) SA_PROC_A(i0 + 8, kb, vb);
        }
#define SA_LOAD_B(i0_, KK, VV) do { _Pragma("unroll") for (int j = 0; j < 8; ++j) { const int idx = F.wave + 8 * ((i0_) + j), p = 16 * (idx >> 2) + (idx & 3); \
                KK[j] = *(const f32x4*)(ck + (size_t)p * 512); VV[j] = *(const f32x4*)(cv + (size_t)p * 512); } } while (0)
#define SA_PROC_B(i0_, KK, VV) do { \
            _Pragma("unroll") for (int j = 0; j < 8; ++j) { const int idx = F.wave + 8 * ((i0_) + j), p = 16 * (idx >> 2) + (idx & 3); \
                if (p >= 4) { __builtin_nontemporal_store(KK[j], (f32x4*)(dk + (size_t)(p - 4) * 512)); __builtin_nontemporal_store(VV[j], (f32x4*)(dv + (size_t)(p - 4) * 512)); } } \
            _Pragma("unroll") for (int j = 0; j < 8; ++j) { const int t = (F.wave + 8 * ((i0_) + j)) & 3;      \
                float s0 = 0.f; \
                _Pragma("unroll") for (int tt = 0; tt < 4; ++tt) if (tt == t) s0 = q[tt][0] * KK[j][0] + q[tt][1] * KK[j][1] + q[tt][2] * KK[j][2] + q[tt][3] * KK[j][3]; \
                const float s = red16(s0); \
                _Pragma("unroll") for (int tt = 0; tt < 4; ++tt) if (tt == t) sa_accum(S, tt, s, 1.0f, VV[j]); } } while (0)
        SA_LOAD_B(0, ka, va);
#pragma unroll 1
        for (int i0 = 0; i0 < 48; i0 += 16) {
            SA_LOAD_B(i0 + 8, kb, vb);
            SA_PROC_B(i0, ka, va);
            if (i0 + 16 < 48) SA_LOAD_B(i0 + 16, ka, va);
            SA_PROC_B(i0 + 8, kb, vb);
        }
#undef SA_LOAD_A
#undef SA_PROC_A
#undef SA_LOAD_B
#undef SA_PROC_B
#pragma unroll
        for (int t = 0; t < 4; ++t) { LAS float* p = mg + ((F.wave * 4 + t) * 6) * 64 + F.lane; p[0] = S.m[t]; p[64] = S.l[t]; p[128] = S.o[t][0]; p[192] = S.o[t][1]; p[256] = S.o[t][2]; p[320] = S.o[t][3]; }
        __syncthreads();
        if (F.wave < 4) { const int t = F.wave; float mm = NEGBIG;
#pragma unroll
            for (int w = 0; w < 8; ++w) mm = fmaxf(mm, mg[((w * 4 + t) * 6) * 64 + F.lane]);
            float L = 0.f; f32x4 o = {0.f, 0.f, 0.f, 0.f};
#pragma unroll
            for (int w = 0; w < 8; ++w) { const LAS float* p = mg + ((w * 4 + t) * 6) * 64 + F.lane; const float f = fexp2(p[0] - mm); L += p[64] * f; o[0] += p[128] * f; o[1] += p[192] * f; o[2] += p[256] * f; o[3] += p[320] * f; }
            const float inv = 1.0f / L; u32x2 w2; w2.x = cvt_pk_bf16(o[0] * inv, o[1] * inv); w2.y = cvt_pk_bf16(o[2] * inv, o[3] * inv);
            *(u32x2*)(MRG + (size_t)(MP + bs * 4 + t) * 1024 + coff) = w2;
            const float ss = row16_sum((o[0] * o[0] + o[1] * o[1] + o[2] * o[2] + o[3] * o[3]) * inv * inv);
            if ((F.lane & 15) == 0) atomicAdd(WSP(float, WS_STAT) + (size_t)(MP + bs * 4 + t) * 2, ss); }
        __syncthreads();
    }
}

__device__ __forceinline__ void sample_s5(const Args& A, Frame& F) {
    const int gw = F.vcu * NWAVES + F.wave, NGW = F.G * NWAVES, n = F.lane; const float* US = WSP(float, WS_US); bf16_t* YG = WSP(bf16_t, WS_YG);
    for (int task = gw; task < 128 * 32; task += NGW) {
        const int bs = task >> 5, g = task & 31;
        const S5n s = s5_setup(A, F, g, n);
        double ar, ai; abar_pow(1.0, s.dt, s.lr, s.li, ar, ai); const float a_r = (float)ar, a_i = (float)ai;
        float hr = A.in[4][((size_t)bs * 32 + g) * 64 + n], hi = A.in[5][((size_t)bs * 32 + g) * 64 + n];
        const float uval = US[(size_t)(bs * 4 + (n >> 4)) * 512 + g * 16 + (n & 15)];
        float yv = 0.f;
#pragma unroll 1
        for (int t = 0; t < 4; ++t) {
            float bur = 0.f, bui = 0.f;
#pragma unroll
            for (int c = 0; c < 16; ++c) { const float u = rdlane(uval, t * 16 + c); const float xr = A.in[18][(g * 64 + n) * 16 + c], xi = A.in[19][(g * 64 + n) * 16 + c];
                bur += (s.cr * xr - s.ci * xi) * u; bui += (s.cr * xi + s.ci * xr) * u; }
            const float nr = a_r * hr - a_i * hi + bur, ni = a_r * hi + a_i * hr + bui; hr = nr; hi = ni;
#pragma unroll
            for (int c = 0; c < 16; ++c) { const float Cr = A.in[20][(g * 16 + c) * 64 + n], Ci = A.in[21][(g * 16 + c) * 64 + n];
                float y = wave_sum(Cr * hr - Ci * hi) + A.in[22][g * 16 + c] * rdlane(uval, t * 16 + c);
                y = gelu_tanh(y); if (n == t * 16 + c) yv = y; }
        }
        YG[(size_t)(MP + bs * 4 + (n >> 4)) * 512 + g * 16 + (n & 15)] = (bf16_t)(cvt_pk_bf16(yv, 0.f) & 0xffffu);
        A.out[OFF_HRS + ((size_t)bs * 32 + g) * 64 + n] = hr; A.out[OFF_HIS + ((size_t)bs * 32 + g) * 64 + n] = hi;
    }
}

__device__ __forceinline__ void s5_carry(const Args& A, Frame& F, const int b, const int g) {
    const int n = F.lane, w = F.wave;
    const S5n s = s5_setup(A, F, g, n);
    double ar, ai; abar_pow(16.0, s.dt, s.lr, s.li, ar, ai); const float a_r = (float)ar, a_i = (float)ai;
    double pr = ar, pi = ai;
#pragma unroll
    for (int k = 0; k < 6; ++k) { const double qr = pr * pr - pi * pi, qi = 2.0 * pr * pi; pr = qr; pi = qi; }
    const float A_r = (float)pr, A_i = (float)pi;
    bf16_t* AP = WSP(bf16_t, WS_AP); const float* SST = WSP(float, WS_SST);
    const size_t row0 = (size_t)g * 1024 + (size_t)b * 512 + (size_t)w * 64;
    float sr[64], si[64];
#pragma unroll
    for (int c = 0; c < 64; ++c) { sr[c] = SST[(row0 + c) * 128 + n]; si[c] = SST[(row0 + c) * 128 + 64 + n]; }
    float er = 0.f, ei = 0.f;
#pragma unroll
    for (int c = 0; c < 64; ++c) { const float nr = a_r * er - a_i * ei + sr[c], ni = a_r * ei + a_i * er + si[c]; er = nr; ei = ni; }
    LAS float* X = (LAS float*)F.lds;
    X[(w * 2) * 64 + n] = er; X[(w * 2 + 1) * 64 + n] = ei;
    __syncthreads();
    float hr = 0.f, hi = 0.f;
#pragma unroll
    for (int j = 0; j < 7; ++j) if (j < w) { const float xr = X[(j * 2) * 64 + n], xi = X[(j * 2 + 1) * 64 + n]; const float nr = A_r * hr - A_i * hi + xr, ni = A_r * hi + A_i * hr + xi; hr = nr; hi = ni; }
#pragma unroll
    for (int c = 0; c < 64; ++c) {
        AP[(row0 + c) * KA + 256 + n] = (bf16_t)(cvt_pk_bf16(hr, 0.f) & 0xffffu); AP[(row0 + c) * KA + 320 + n] = (bf16_t)(cvt_pk_bf16(hi, 0.f) & 0xffffu);
        const float nr = a_r * hr - a_i * hi + sr[c], ni = a_r * hi + a_i * hr + si[c]; hr = nr; hi = ni;
    }
    if (w == 7) { A.out[OFF_HRP + ((size_t)b * 32 + g) * 64 + n] = hr; A.out[OFF_HIP + ((size_t)b * 32 + g) * 64 + n] = hi; }
    __syncthreads();
}

constexpr int NPHASE = 13;
__global__ void __launch_bounds__(NWAVES * 64, 2) mk_fwd(Args args) {
    const Args& A = args;
    extern __shared__ __attribute__((aligned(16))) unsigned char lds_raw[];
    Frame F;
    F.lds = (LAS unsigned char*)lds_raw;
    F.tid = threadIdx.x; F.lane = F.tid & 63; F.wave = __builtin_amdgcn_readfirstlane(F.tid >> 6);
    F.G = gridDim.x; { const int bx = blockIdx.x; F.vcu = (F.G % 8 == 0) ? (bx % 8) * (F.G / 8) + bx / 8 : bx; }
    volatile LAS unsigned* MISC = (volatile LAS unsigned*)(F.lds + MISC_OFF);
    for (int u = F.tid; u < (LDS_BYTES - LDSCTL_OFF) / 4; u += NWAVES * 64) ((LAS unsigned*)(F.lds + LDSCTL_OFF))[u] = 0u;
    __syncthreads();
    unsigned* ctl = (unsigned*)(A.ws + WS_CTL);
    XcdBarrier bar; bar.bar = ctl + CW_BAR; bar.x = 0; bar.st = nullptr;
#if !MK_MULTI
    bar = xcd_barrier_post(ctl + CW_BAR, MISC + 8);
#define GRID_BAR() xcd_barrier(bar)
#else
#define GRID_BAR() do { } while (0)
#endif
    const int lo = args.ph_lo, hi = args.ph_hi;
#define IN(k) (lo <= (k) && (k) < hi)
#define BOTH(k) (IN(k) && IN((k) + 1))
    LAS unsigned char* ring = F.lds;

    if (IN(0)) { p0_prologue(A, F); if (BOTH(0)) GRID_BAR(); }
    if (IN(1)) {
        constexpr int GG = 24;
        if (F.vcu < GG) {
        pg8::StaticOrder S{(const char*)WSP(bf16_t, WS_CS), (const char*)WSP(bf16_t, WS_WADA), 1, NMOD / 256, GG, F.vcu, (size_t)256 * D * 2, (size_t)256 * D * 2};
        EpiMod E{WSP(float, WS_MOD), A.in[11]};
        pg8::gemm_phase<EpiMod, pg8::StaticOrder, true>(ring, D, D, D, S, E);
        } else p1_side_work(A, F, F.vcu - GG, F.G - GG);
        if (BOTH(1)) GRID_BAR();
    }
    if (IN(2)) { norm_mod_pass<false>(A, F, A.in[0], A.in[1], A.in[8], 0, 1024, WSP(bf16_t, WS_XN), 0, M, F.vcu * NWAVES + F.wave, F.G * NWAVES); if (BOTH(2)) GRID_BAR(); }
    if (IN(3)) {
        { pg8::StaticOrder S{(const char*)WSP(bf16_t, WS_XN), (const char*)WSP(bf16_t, WS_WIN), MP / 256, NIN / 256, F.G, F.vcu, (size_t)256 * D * 2, (size_t)256 * D * 2};
        EpiIn E{WSP(bf16_t, WS_Q), WSP(bf16_t, WS_K), WSP(bf16_t, WS_V), WSP(bf16_t, WS_AP), WSP(float, WS_QS), WSP(float, WS_US), A.out, A.in[13], A.in[14]};
        pg8::gemm_phase<EpiIn, pg8::StaticOrder, true>(ring, D, D, D, S, E); }
        if (BOTH(3)) GRID_BAR();
    }
    if (IN(4)) {
        constexpr int NPW = 128, NSU = 2 * (NIN / 256);
        const bool roleA = F.vcu >= NPW; const int va = F.vcu - NPW; const bool proj = roleA && va < NSU;
        if (roleA) {
        { pg8::GroupOrder S{(const char*)WSP(bf16_t, WS_AP), (const char*)WSP(bf16_t, WS_WEND), 128, F.G - NPW, va, (size_t)256 * KA * 2, (size_t)256 * 256 * 2};
          EpiSt E{WSP(float, WS_SST)};
          pg8::gemm_phase<EpiSt, pg8::GroupOrder, true>(ring, 256, KA, 256, S, E); }
        asm volatile("s_waitcnt vmcnt(0)" ::: "memory"); __syncthreads();
        { unsigned* cw = (unsigned*)(A.ws + WS_CTL) + CW_S5C + 64 * (va >> 1);
          if (F.tid == 0) __hip_atomic_fetch_add(cw, 1u, __ATOMIC_RELAXED, __HIP_MEMORY_SCOPE_AGENT);
          if ((va & 1) == 0) {
              if (F.tid == 0) { unsigned sp = 0; unsigned* tmo = (unsigned*)(A.ws + WS_CTL) + CW_BAR + XB_TMO;
                  while (__hip_atomic_load(cw, __ATOMIC_RELAXED, __HIP_MEMORY_SCOPE_AGENT) < 2u) { __builtin_amdgcn_s_sleep(1);
                      if ((++sp & 255u) == 0u) { if (xb_ld(tmo)) break; if (sp > XB_SPIN_CAP) { atomicAdd(tmo, 1u); break; } } } }
              __syncthreads();
              __builtin_amdgcn_fence(__ATOMIC_ACQUIRE, "agent"); asm volatile("s_waitcnt vmcnt(0)" ::: "memory");
              s5_carry(A, F, (va >> 1) & 1, va >> 2);
          } }
        __syncthreads(); }
        if (proj) {
            pg8::StaticOrder S{(const char*)WSP(bf16_t, WS_XN), (const char*)WSP(bf16_t, WS_WIN), M / 256, NIN / 256, 1 << 20, (MP / 256) * (NIN / 256) + va, (size_t)256 * D * 2, (size_t)256 * D * 2};
            EpiIn E{WSP(bf16_t, WS_Q), WSP(bf16_t, WS_K), WSP(bf16_t, WS_V), WSP(bf16_t, WS_AP), WSP(float, WS_QS), WSP(float, WS_US), A.out, A.in[13], A.in[14]};
            pg8::gemm_phase<EpiIn, pg8::StaticOrder, true>(ring, D, D, D, S, E);
            signal_done(A, F, 4);
            __syncthreads();
        } else {
            prompt_attention(A, F, roleA ? 256 + va : F.vcu, 128, 2, F.vcu < 2 * NSU ? 256 + (F.vcu & (NSU - 1)) + 128 * (F.vcu >> 4) : -1);
            __syncthreads();
        }
        { if (F.tid == 0) { unsigned sp = 0; unsigned* dw = DONE_WORD(4) + 64 * (F.vcu & 7); unsigned* tmo = (unsigned*)(A.ws + WS_CTL) + CW_BAR + XB_TMO;
              while (__hip_atomic_load(dw, __ATOMIC_RELAXED, __HIP_MEMORY_SCOPE_AGENT) < 16u) { __builtin_amdgcn_s_sleep(2);
                  if ((++sp & 255u) == 0u) { if (xb_ld(tmo)) break; if (sp > XB_SPIN_CAP) { atomicAdd(tmo, 1u); break; } } } }
          __syncthreads();
          __builtin_amdgcn_fence(__ATOMIC_ACQUIRE, "agent"); asm volatile("s_waitcnt vmcnt(0)" ::: "memory"); }
        sample_attention(A, F, 1 << 30);
        sample_s5(A, F);
        if (BOTH(4)) GRID_BAR();
    }
    if (IN(6)) {
        constexpr int GG = 128;
        if (F.vcu < GG) {
        pg8::GroupOrder S{(const char*)WSP(bf16_t, WS_AP), (const char*)WSP(bf16_t, WS_TMAT), 128, GG, F.vcu, (size_t)256 * KA * 2, (size_t)256 * KA * 2};
        EpiY E{WSP(bf16_t, WS_YG)};
        pg8::gemm_phase<EpiY, pg8::GroupOrder, true>(ring, KA, KA, KA, S, E); }
        if (BOTH(6)) GRID_BAR();
    }
    if (IN(7)) {
        constexpr int GG = 132;
        if (F.vcu < GG) {
        pg8::StaticOrder S{(const char*)WSP(bf16_t, WS_YG), (const char*)WSP(bf16_t, WS_WGLU), M / 256, 2, GG, F.vcu, (size_t)256 * 512 * 2, (size_t)256 * 512 * 2};
        EpiGlu E{WSP(bf16_t, WS_YG), WSP(bf16_t, WS_MRG), WSP(float, WS_STAT)};
        pg8::gemm_phase<EpiGlu, pg8::StaticOrder, true>(ring, 512, 512, 512, S, E); }
        if (BOTH(7)) GRID_BAR();
    }
    if (IN(9)) {
        { pg8::StaticOrder S{(const char*)WSP(bf16_t, WS_MRG), (const char*)WSP(bf16_t, WS_WOUT), MP / 256, D / 256, F.G, F.vcu, (size_t)256 * D * 2, (size_t)256 * D * 2};
        EpiOut E{A.in[0], A.in[1], WSP(float, WS_MOD), WSP(float, WS_STAT), WSP(bf16_t, WS_X1)};
        pg8::gemm_phase<EpiOut, pg8::StaticOrder, true>(ring, D, D, D, S, E); }
        if (BOTH(9)) GRID_BAR();
    }
    if (IN(10)) { norm_mod_pass<true>(A, F, WSP(bf16_t, WS_X1), WSP(bf16_t, WS_X1) + (size_t)MP * D, A.in[9], 3072, 4096, WSP(bf16_t, WS_XN), 0, MP, F.vcu * NWAVES + F.wave, F.G * NWAVES); if (BOTH(10)) GRID_BAR(); }
    if (IN(11)) {
        constexpr int GG = 242, NS = 14, NSO = 2 * (D / 256);
        if (F.vcu < GG) {
        pg8::StaticOrder S{(const char*)WSP(bf16_t, WS_XN), (const char*)WSP(bf16_t, WS_WGU), MP / 256, NGU / 256, GG, F.vcu, (size_t)256 * D * 2, (size_t)256 * D * 2};
        EpiGU E{WSP(bf16_t, WS_HB)};
        pg8::gemm_phase<EpiGU, pg8::StaticOrder, true>(ring, D, D, D, S, E); }
        else {
            const int r = F.vcu - GG;
            if (r < NSO) {
                pg8::StaticOrder S{(const char*)WSP(bf16_t, WS_MRG), (const char*)WSP(bf16_t, WS_WOUT), M / 256, D / 256, 1 << 20, (MP / 256) * (D / 256) + r, (size_t)256 * D * 2, (size_t)256 * D * 2};
                EpiOut E{A.in[0], A.in[1], WSP(float, WS_MOD), WSP(float, WS_STAT), WSP(bf16_t, WS_X1)};
                pg8::gemm_phase<EpiOut, pg8::StaticOrder, true>(ring, D, D, D, S, E);
                signal_done(A, F, 10);
            }
            wait_done(A, F, 10, NSO);
            norm_mod_pass<true>(A, F, WSP(bf16_t, WS_X1), WSP(bf16_t, WS_X1) + (size_t)MP * D, A.in[9], 3072, 4096, WSP(bf16_t, WS_XN), MP, M, r * NWAVES + F.wave, NS * NWAVES, true);
            signal_done(A, F, 9);
            wait_done(A, F, 9, NS);
            { pg8::StaticOrder S{(const char*)WSP(bf16_t, WS_XN), (const char*)WSP(bf16_t, WS_WGU), M / 256, NGU / 256, NS, (MP / 256) * (NGU / 256) + r, (size_t)256 * D * 2, (size_t)256 * D * 2};
              EpiGU E{WSP(bf16_t, WS_HB)};
              pg8::gemm_phase<EpiGU, pg8::StaticOrder, true>(ring, D, D, D, S, E); }
        }
        if (BOTH(11)) GRID_BAR();
    }
    if (IN(12)) {
        constexpr int GG = 88;
        if (F.vcu < GG) {
        pg8::StaticOrder S{(const char*)WSP(bf16_t, WS_HB), (const char*)WSP(bf16_t, WS_WDN), M / 256, D / 256, GG, F.vcu, (size_t)256 * FF * 2, (size_t)256 * FF * 2};
        EpiDown E{WSP(bf16_t, WS_X1), WSP(float, WS_MOD), A.out};
        pg8::gemm_phase<EpiDown, pg8::StaticOrder, true>(ring, FF, FF, FF, S, E); }
        stream_copy(A, F, nullptr, 0u);
    }
#undef IN
#undef BOTH
}

extern "C" void kernel_launch(void* const* d_in, const int* in_sizes, int n_in, void* d_out, int out_size, void* d_ws, size_t ws_size, hipStream_t stream) {
    static int grid = 0;
    if (grid == 0) {
        if (n_in != 30 || ws_size < WS_END) { fprintf(stderr, "kernel_launch: unexpected n_in %d / ws %zu\n", n_in, ws_size); grid = -1; return; }
        int dev = 0, cus = 0;
        if (hipGetDevice(&dev) != hipSuccess || hipDeviceGetAttribute(&cus, hipDeviceAttributeMultiprocessorCount, dev) != hipSuccess) { grid = -1; return; }
        if (hipFuncSetAttribute((const void*)mk_fwd, hipFuncAttributeMaxDynamicSharedMemorySize, LDS_BYTES) != hipSuccess) { fprintf(stderr, "kernel_launch: hipFuncSetAttribute failed\n"); grid = -1; return; }
        int per_cu = 0;
        if (hipOccupancyMaxActiveBlocksPerMultiprocessor(&per_cu, (const void*)mk_fwd, NWAVES * 64, LDS_BYTES) != hipSuccess || per_cu < 1) fprintf(stderr, "kernel_launch: occupancy query says %d\n", per_cu);
        (void)hipGetLastError();
        grid = cus;
    }
    if (grid < 0) return;
    (void)hipMemsetAsync((char*)d_ws + WS_CTL, 0, CTL_ZERO_BYTES, stream);
    Args a{};
    for (int i = 0; i < 30; ++i) a.in[i] = (const float*)d_in[i];
    a.out = (float*)d_out; a.ws = (unsigned char*)d_ws;
#if MK_MULTI
    for (int p = 0; p < NPHASE; ++p) { a.ph_lo = p; a.ph_hi = p + 1; hipLaunchKernelGGL(mk_fwd, dim3(grid), dim3(NWAVES * 64), LDS_BYTES, stream, a); }
#else
    a.ph_lo = 0; a.ph_hi = NPHASE; hipLaunchKernelGGL(mk_fwd, dim3(grid), dim3(NWAVES * 64), LDS_BYTES, stream, a);
#endif
}
```
